# Optimizing an MI355X kernel written in HIP

```python
import math
import jax
import jax.numpy as jnp
from jax import lax
import numpy as np

D_MODEL = 1024
BATCH = 32
SEQ = 2048
DEPTH = 2

CTX_LEN = 256
GRID_W = 64
NORM_EPS = 1e-6

RW_HEADS = 8
RW_HEAD = 64
RW_DIM = 512
RW_DECAY_LORA = 64
RW_ICL_LORA = 64
RW_GATE_LORA = 128
RW_GN_EPS = 64e-5
RW_SPLITS = (512, 512, 512, 64, 64, 64, 64, 128)
RW_COLS = 1920

SSM_HEADS = 16
SSM_HEAD = 64
SSM_DIM = 1024
SSM_GROUPS = 2
SSM_STATE = 128
SSM_CONV = 5
SSM_CHUNK = 64
XBC_DIM = 1536
EVEN_COLS = 4512
MIX_DIM = 1536

MLA_HEADS = 16
MLA_Q_LORA = 384
MLA_KV_LORA = 256
MLA_NOPE = 64
MLA_ROPE = 32
MLA_V = 64
ODD_COLS = 672
ROPE_THETA = 10000.0
Q_BLOCK = 128

N_EXPERTS = 64
TOP_K = 6
N_EXPERT_GROUPS = 8
TOPK_GROUPS = 4
EXPERT_FF = 256
SHARED_FF = 256
ROUTED_SCALE = 2.5

kernel_name = "hybrid_rwkv7_mamba2_mla_moe_prefix_dit"


def split_sizes(u, sizes):
    return jnp.split(u, np.cumsum(sizes)[:-1].tolist(), axis=-1)


def rms_normalize(u, eps=NORM_EPS):
    u32 = u.astype(jnp.float32)
    return (u32 * lax.rsqrt(jnp.mean(u32 * u32, axis=-1, keepdims=True) + eps)).astype(u.dtype)


def rmsnorm(u, g):
    return rms_normalize(u) * g


def modulate(h, shift, scale):
    return h * (1 + scale) + shift


def axial_rope_tables(n_tokens, dtype):
    rows = n_tokens // GRID_W
    r_idx, c_idx = jnp.meshgrid(jnp.arange(rows), jnp.arange(GRID_W), indexing='ij')
    r_idx = r_idx.reshape(-1).astype(jnp.float32)
    c_idx = c_idx.reshape(-1).astype(jnp.float32)
    axis_dim = MLA_ROPE // 2
    inv_freq = ROPE_THETA ** (-jnp.arange(0, axis_dim, 2, dtype=jnp.float32) / axis_dim)
    ang = jnp.concatenate([r_idx[:, None] * inv_freq, c_idx[:, None] * inv_freq], axis=-1)
    return jnp.cos(ang).astype(dtype), jnp.sin(ang).astype(dtype)


def apply_rope(u, cos, sin):
    u1, u2 = jnp.split(u, 2, axis=-1)
    return jnp.concatenate([u1 * cos - u2 * sin, u1 * sin + u2 * cos], axis=-1)


def bidir_shift_mix(p, mu):
    zero = jnp.zeros_like(p[:, :1])
    prev = jnp.concatenate([zero, p[:, :-1]], axis=1)
    nxt = jnp.concatenate([p[:, 1:], zero], axis=1)
    return p + mu * (0.5 * (prev + nxt) - p)


def depthwise_conv_centred(u, w, b):
    k = w.shape[0]
    out = lax.conv_general_dilated(u, w[:, None, :], window_strides=(1,), padding=[(k // 2, k // 2)],
                                   dimension_numbers=('NWC', 'WIO', 'NWC'), feature_group_count=u.shape[-1])
    return out + b


def rwkv7_scan(r, w, k, v, kk, b, s0, reverse):
    def step(s, inp):
        r_t, w_t, k_t, v_t, kk_t, b_t = inp
        sa = jnp.einsum('bhvk,bhk->bhv', s, kk_t)
        s = s * w_t[:, :, None, :] - sa[..., None] * b_t[:, :, None, :] + v_t[..., None] * k_t[:, :, None, :]
        return s, jnp.einsum('bhvk,bhk->bhv', s, r_t)
    xs = tuple(jnp.moveaxis(u, 1, 0) for u in (r, w, k, v, kk, b))
    s_fin, ys = lax.scan(step, s0, xs, reverse=reverse)
    return jnp.moveaxis(ys, 0, 1), s_fin


def rwkv7_branch(cols, s_fwd, s_bwd, mu, w0, w2, a0, a2, g2, k_k, k_a, r_k, gn_w, gn_b):
    bsz, t = cols.shape[:2]

    def hd(u):
        return u.reshape(*u.shape[:-1], RW_HEADS, RW_HEAD)

    cols = bidir_shift_mix(cols, mu)
    r, k, v, xw_f, xw_b, xa_f, xa_b, xg = split_sizes(cols, RW_SPLITS)
    kk = hd(k * k_k).astype(jnp.float32)
    kk = (kk * lax.rsqrt(jnp.sum(kk * kk, axis=-1, keepdims=True) + 1e-12)).astype(k.dtype)
    ys, ks, finals = [], [], []
    for d, (xw, xa, s0, rev) in enumerate(((xw_f, xa_f, s_fwd, False), (xw_b, xa_b, s_bwd, True))):
        w_log = -jax.nn.softplus(-(w0[d] + jnp.tanh(xw) @ w2[d])) - 0.5
        decay = jnp.exp(-jnp.exp(w_log))
        a = jax.nn.sigmoid(a0[d] + xa @ a2[d])
        k_d = k * (1 + (a - 1) * k_a)
        y, s_fin = rwkv7_scan(hd(r), hd(decay), hd(k_d), hd(v), kk, kk * hd(a), s0, rev)
        ys.append(y)
        ks.append(k_d)
        finals.append(s_fin)
    y = ys[0] + ys[1]
    mean = jnp.mean(y, axis=-1, keepdims=True)
    var = jnp.mean(jnp.square(y - mean), axis=-1, keepdims=True)
    y = ((y - mean) * lax.rsqrt(var + RW_GN_EPS)).astype(r.dtype) * hd(gn_w) + hd(gn_b)
    bonus = jnp.sum(hd(r) * hd(ks[0] + ks[1]) * hd(r_k), axis=-1, keepdims=True) * hd(v)
    g = jax.nn.sigmoid(xg) @ g2
    out = (y + bonus).reshape(bsz, t, RW_DIM) * g
    return out, finals[0], finals[1]


def ssd_scan(xs, dt, a_neg, bm, cm, s0):
    b, t, h, p = xs.shape
    g, n = bm.shape[2], bm.shape[3]
    j = h // g
    nc = t // SSM_CHUNK
    cl = SSM_CHUNK
    da = (dt.astype(jnp.float32) * a_neg.astype(jnp.float32)).reshape(b, nc, cl, h)
    cs = jnp.cumsum(da, axis=2)
    xdt = (xs * dt[..., None]).reshape(b, nc, cl, g, j, p)
    bc = bm.reshape(b, nc, cl, g, n)
    cc = cm.reshape(b, nc, cl, g, n)
    causal = jnp.tril(jnp.ones((cl, cl), bool))
    seg = cs[:, :, :, None, :] - cs[:, :, None, :, :]
    lmat = jnp.exp(jnp.where(causal[:, :, None], seg, -jnp.inf)).reshape(b, nc, cl, cl, g, j).astype(xs.dtype)
    cb = jnp.einsum('bclgn,bcsgn->bclsg', cc, bc)
    y_diag = jnp.einsum('bclsg,bclsgj,bcsgjp->bclgjp', cb, lmat, xdt)
    decay_to_end = jnp.exp(cs[:, :, -1:, :] - cs).reshape(b, nc, cl, g, j).astype(xs.dtype)
    states = jnp.einsum('bclgn,bclgj,bclgjp->bcgjpn', bc, decay_to_end, xdt).reshape(b, nc, h, p, n)
    chunk_decay = jnp.exp(cs[:, :, -1, :])

    def step(s, inp):
        dec, st = inp
        return s * dec[:, :, None, None] + st, s

    s_fin, s_in = lax.scan(step, s0, (jnp.moveaxis(chunk_decay, 1, 0),
                                      jnp.moveaxis(states.astype(jnp.float32), 1, 0)))
    s_in = jnp.moveaxis(s_in, 0, 1).reshape(b, nc, g, j, p, n).astype(xs.dtype)
    decay_from_start = jnp.exp(cs).reshape(b, nc, cl, g, j).astype(xs.dtype)
    y_off = jnp.einsum('bclgn,bcgjpn,bclgj->bclgjp', cc, s_in, decay_from_start)
    return (y_diag + y_off).reshape(b, t, h, p), s_fin


def mamba2_branch(z, xbc, dt_raw, s_fwd, s_bwd, conv_w, conv_b, dt_bias, a_log, d_skip, norm_w):
    bsz, t = z.shape[:2]
    xbc = jax.nn.silu(depthwise_conv_centred(xbc, conv_w, conv_b))
    xs, bm, cm = split_sizes(xbc, (SSM_DIM, SSM_GROUPS * SSM_STATE, SSM_GROUPS * SSM_STATE))
    xs = xs.reshape(bsz, t, SSM_HEADS, SSM_HEAD)
    bm = bm.reshape(bsz, t, SSM_GROUPS, SSM_STATE)
    cm = cm.reshape(bsz, t, SSM_GROUPS, SSM_STATE)
    dt = jax.nn.softplus(dt_raw.reshape(bsz, t, 2, SSM_HEADS) + dt_bias)
    a_neg = -jnp.exp(a_log)
    y_f, s_f = ssd_scan(xs, dt[:, :, 0], a_neg[0], bm, cm, s_fwd)
    flip = lambda u: jnp.flip(u, axis=1)
    y_b, s_b = ssd_scan(flip(xs), flip(dt[:, :, 1]), a_neg[1], flip(bm), flip(cm), s_bwd)
    y = y_f + flip(y_b) + xs * d_skip[:, None]
    y = (y.reshape(bsz, t, SSM_DIM) * jax.nn.silu(z)).reshape(bsz, t, SSM_GROUPS, SSM_DIM // SSM_GROUPS)
    y = rms_normalize(y).reshape(bsz, t, SSM_DIM) * norm_w
    return y, s_f, s_b


def even_mixer(h_lat, h_ctx, w_in, w_out, rw_mu, rw_w0, rw_w2, rw_a0, rw_a2, rw_g2, rw_kk, rw_ka, rw_rk,
               rw_gn_w, rw_gn_b, conv_w, conv_b, dt_bias, a_log, d_skip, ssm_norm_w):
    bsz = h_lat.shape[0]
    rw_f = rw_b = jnp.zeros((bsz, RW_HEADS, RW_HEAD, RW_HEAD), jnp.float32)
    ss_f = ss_b = jnp.zeros((bsz, SSM_HEADS, SSM_HEAD, SSM_STATE), jnp.float32)
    outs = []
    for h in (h_ctx, h_lat):
        rw_cols, z, xbc, dt_raw = split_sizes(h @ w_in, (RW_COLS, SSM_DIM, XBC_DIM, 2 * SSM_HEADS))
        y_rw, rw_f, rw_b = rwkv7_branch(rw_cols, rw_f, rw_b, rw_mu, rw_w0, rw_w2, rw_a0, rw_a2, rw_g2,
                                        rw_kk, rw_ka, rw_rk, rw_gn_w, rw_gn_b)
        y_ss, ss_f, ss_b = mamba2_branch(z, xbc, dt_raw, ss_f, ss_b, conv_w, conv_b, dt_bias, a_log,
                                         d_skip, ssm_norm_w)
        outs.append(jnp.concatenate([y_rw, y_ss], axis=-1) @ w_out)
    return outs[1], outs[0]


def block_attention(qn, qr, kn, kr, v, scale):
    b, t, h, _ = qn.shape
    nb = t // Q_BLOCK

    def to_blocks(u):
        return jnp.moveaxis(u.reshape(b, nb, Q_BLOCK, *u.shape[2:]), 1, 0)

    def one_block(q_pair):
        qn_i, qr_i = q_pair
        s = jnp.einsum('bqhd,bkhd->bhqk', qn_i, kn) + jnp.einsum('bqhr,bkr->bhqk', qr_i, kr)
        pr = jax.nn.softmax(s.astype(jnp.float32) * scale, axis=-1).astype(v.dtype)
        return jnp.einsum('bhqk,bkhd->bqhd', pr, v)

    out = lax.map(one_block, (to_blocks(qn), to_blocks(qr)))
    return jnp.moveaxis(out, 0, 1).reshape(b, t, h, v.shape[-1])


def mla_mixer(h_lat, h_ctx, w_in, q_norm, q_up, kv_norm, kv_up, w_out, cos, sin, need_ctx):
    scale = (MLA_NOPE + MLA_ROPE) ** -0.5

    def split_heads(u, width):
        return u.reshape(u.shape[0], u.shape[1], MLA_HEADS, width)

    def queries(cq):
        q = split_heads(rmsnorm(cq, q_norm) @ q_up, MLA_NOPE + MLA_ROPE)
        return q[..., :MLA_NOPE], q[..., MLA_NOPE:]

    def keys_values(ckv):
        kv = split_heads(rmsnorm(ckv, kv_norm) @ kv_up, MLA_NOPE + MLA_V)
        return kv[..., :MLA_NOPE], kv[..., MLA_NOPE:]

    bsz, t = h_lat.shape[:2]
    cq_l, ckv_l, kr_l = split_sizes(h_lat @ w_in, (MLA_Q_LORA, MLA_KV_LORA, MLA_ROPE))
    cq_c, ckv_c, kr_c = split_sizes(h_ctx @ w_in, (MLA_Q_LORA, MLA_KV_LORA, MLA_ROPE))
    qn_l, qr_l = queries(cq_l)
    qr_l = apply_rope(qr_l, cos[:, None, :], sin[:, None, :])
    kr_l = apply_rope(kr_l, cos, sin)
    kn_l, v_l = keys_values(ckv_l)
    kn_c, v_c = keys_values(ckv_c)
    kn = jnp.concatenate([kn_c, kn_l], axis=1)
    kr = jnp.concatenate([kr_c, kr_l], axis=1)
    v = jnp.concatenate([v_c, v_l], axis=1)
    out_l = block_attention(qn_l, qr_l, kn, kr, v, scale).reshape(bsz, t, MLA_HEADS * MLA_V) @ w_out
    out_c = None
    if need_ctx:
        qn_c, qr_c = queries(cq_c)
        out_c = block_attention(qn_c, qr_c, kn_c, kr_c, v_c, scale).reshape(
            bsz, h_ctx.shape[1], MLA_HEADS * MLA_V) @ w_out
    return out_l, out_c


def moe_ffn(tok, router_w, router_bias, w1, w3, w2, sw1, sw3, sw2):
    logits = (tok @ router_w).astype(jnp.float32)
    scores = jax.nn.sigmoid(logits)
    sel = scores + router_bias
    grp = sel.reshape(-1, N_EXPERT_GROUPS, N_EXPERTS // N_EXPERT_GROUPS)
    grp_score = jnp.sum(lax.top_k(grp, 2)[0], axis=-1)
    _, gidx = lax.top_k(grp_score, TOPK_GROUPS)
    gmask = jnp.sum(jax.nn.one_hot(gidx, N_EXPERT_GROUPS, dtype=jnp.float32), axis=-2)
    emask = jnp.repeat(gmask, N_EXPERTS // N_EXPERT_GROUPS, axis=-1)
    sel = jnp.where(emask > 0, sel, -jnp.inf)
    _, eidx = lax.top_k(sel, TOP_K)
    wts = jnp.take_along_axis(scores, eidx, axis=-1)
    wts = wts / jnp.sum(wts, axis=-1, keepdims=True) * ROUTED_SCALE
    gates = jnp.sum(jax.nn.one_hot(eidx, N_EXPERTS, dtype=jnp.float32) * wts[..., None], axis=-2).astype(tok.dtype)

    def expert_step(acc, ew):
        w1e, w3e, w2e, ge = ew
        hid = jax.nn.silu(tok @ w1e) * (tok @ w3e)
        return acc + ge[:, None] * (hid @ w2e), None

    routed, _ = lax.scan(expert_step, jnp.zeros_like(tok), (w1, w3, w2, gates.T))
    shared = (jax.nn.silu(tok @ sw1) * (tok @ sw3)) @ sw2
    return routed + shared


def setup_inputs(seed: int = 0) -> dict:
    key = jax.random.key(seed)
    keys = iter(jax.random.split(key, 64))
    f32 = jnp.float32
    d = D_MODEL
    ne, no = (DEPTH + 1) // 2, DEPTH // 2

    def nrm(shape, scale):
        return jax.random.normal(next(keys), shape, f32) * scale

    def gain(shape):
        return 1.0 + nrm(shape, 0.02)

    def unif(shape, lo, hi):
        return jax.random.uniform(next(keys), shape, f32, lo, hi)

    dt0 = jnp.exp(unif((ne, 2, SSM_HEADS), math.log(1e-3), math.log(1e-1)))
    return {
        "x": nrm((BATCH, SEQ, d), 1.0),
        "c": nrm((BATCH, d), 1.0),
        "ctx": nrm((BATCH, CTX_LEN, d), 1.0),
        "c_ctx": nrm((d,), 1.0),
        "ada_w": nrm((DEPTH, d, 6 * d), 0.5 * d ** -0.5),
        "ada_b": nrm((DEPTH, 6 * d), 0.01),
        "norm_mix": gain((DEPTH, d)),
        "norm_ffn": gain((DEPTH, d)),
        "ev_w_in": nrm((ne, d, EVEN_COLS), d ** -0.5),
        "ev_w_out": nrm((ne, MIX_DIM, d), MIX_DIM ** -0.5),
        "rw_mu": unif((ne, RW_COLS), 0.0, 1.0),
        "rw_w0": unif((ne, 2, RW_DIM), -6.0, -1.0),
        "rw_w2": nrm((ne, 2, RW_DECAY_LORA, RW_DIM), 0.5 * RW_DECAY_LORA ** -0.5),
        "rw_a0": nrm((ne, 2, RW_DIM), 0.1),
        "rw_a2": nrm((ne, 2, RW_ICL_LORA, RW_DIM), RW_ICL_LORA ** -0.5),
        "rw_g2": nrm((ne, RW_GATE_LORA, RW_DIM), RW_GATE_LORA ** -0.5),
        "rw_kk": 0.85 + nrm((ne, RW_DIM), 0.02),
        "rw_ka": 1.0 + nrm((ne, RW_DIM), 0.02),
        "rw_rk": nrm((ne, RW_DIM), 0.1),
        "rw_gn_w": gain((ne, RW_DIM)),
        "rw_gn_b": nrm((ne, RW_DIM), 0.01),
        "ssm_conv_w": nrm((ne, SSM_CONV, XBC_DIM), SSM_CONV ** -0.5),
        "ssm_conv_b": nrm((ne, XBC_DIM), 0.01),
        "ssm_dt_bias": dt0 + jnp.log(-jnp.expm1(-dt0)),
        "ssm_a_log": jnp.log(unif((ne, 2, SSM_HEADS), 1.0, 16.0)),
        "ssm_d": gain((ne, SSM_HEADS)),
        "ssm_norm_w": gain((ne, SSM_DIM)),
        "mla_w_in": nrm((no, d, ODD_COLS), d ** -0.5),
        "mla_q_norm": gain((no, MLA_Q_LORA)),
        "mla_q_up": nrm((no, MLA_Q_LORA, MLA_HEADS * (MLA_NOPE + MLA_ROPE)), MLA_Q_LORA ** -0.5),
        "mla_kv_norm": gain((no, MLA_KV_LORA)),
        "mla_kv_up": nrm((no, MLA_KV_LORA, MLA_HEADS * (MLA_NOPE + MLA_V)), MLA_KV_LORA ** -0.5),
        "mla_w_out": nrm((no, MLA_HEADS * MLA_V, d), (MLA_HEADS * MLA_V) ** -0.5),
        "router_w": nrm((DEPTH, d, N_EXPERTS), d ** -0.5),
        "router_bias": nrm((DEPTH, N_EXPERTS), 0.01),
        "exp_w1": nrm((DEPTH, N_EXPERTS, d, EXPERT_FF), d ** -0.5),
        "exp_w3": nrm((DEPTH, N_EXPERTS, d, EXPERT_FF), d ** -0.5),
        "exp_w2": nrm((DEPTH, N_EXPERTS, EXPERT_FF, d), 0.5 * EXPERT_FF ** -0.5),
        "sh_w1": nrm((DEPTH, d, SHARED_FF), d ** -0.5),
        "sh_w3": nrm((DEPTH, d, SHARED_FF), d ** -0.5),
        "sh_w2": nrm((DEPTH, SHARED_FF, d), 0.5 * SHARED_FF ** -0.5),
        "final_norm": gain((d,)),
    }


def reference(x, c, ctx, c_ctx, ada_w, ada_b, norm_mix, norm_ffn,
              ev_w_in, ev_w_out, rw_mu, rw_w0, rw_w2, rw_a0, rw_a2, rw_g2, rw_kk, rw_ka, rw_rk,
              rw_gn_w, rw_gn_b, ssm_conv_w, ssm_conv_b, ssm_dt_bias, ssm_a_log, ssm_d, ssm_norm_w,
              mla_w_in, mla_q_norm, mla_q_up, mla_kv_norm, mla_kv_up, mla_w_out,
              router_w, router_bias, exp_w1, exp_w3, exp_w2, sh_w1, sh_w3, sh_w2, final_norm):
    cos, sin = axial_rope_tables(x.shape[1], x.dtype)
    xl, xc = x, ctx
    silu_c, silu_cc = jax.nn.silu(c), jax.nn.silu(c_ctx)
    for i in range(DEPTH):
        last = i == DEPTH - 1
        mod_l = jnp.split((silu_c @ ada_w[i] + ada_b[i])[:, None, :], 6, axis=-1)
        mod_c = jnp.split(silu_cc @ ada_w[i] + ada_b[i], 6, axis=-1)
        hl = modulate(rmsnorm(xl, norm_mix[i]), mod_l[0], mod_l[1])
        hc = modulate(rmsnorm(xc, norm_mix[i]), mod_c[0], mod_c[1])
        if i % 2 == 0:
            e = i // 2
            ol, oc = even_mixer(hl, hc, ev_w_in[e], ev_w_out[e], rw_mu[e], rw_w0[e], rw_w2[e], rw_a0[e],
                                rw_a2[e], rw_g2[e], rw_kk[e], rw_ka[e], rw_rk[e], rw_gn_w[e], rw_gn_b[e],
                                ssm_conv_w[e], ssm_conv_b[e], ssm_dt_bias[e], ssm_a_log[e], ssm_d[e],
                                ssm_norm_w[e])
        else:
            o = i // 2
            ol, oc = mla_mixer(hl, hc, mla_w_in[o], mla_q_norm[o], mla_q_up[o], mla_kv_norm[o],
                               mla_kv_up[o], mla_w_out[o], cos, sin, not last)
        xl = xl + mod_l[2] * ol
        hl = modulate(rmsnorm(xl, norm_ffn[i]), mod_l[3], mod_l[4])
        bsz, t, d = hl.shape
        if last:
            f_l = moe_ffn(hl.reshape(-1, d), router_w[i], router_bias[i], exp_w1[i], exp_w3[i], exp_w2[i],
                          sh_w1[i], sh_w3[i], sh_w2[i])
            xl = xl + mod_l[5] * f_l.reshape(bsz, t, d)
        else:
            xc = xc + mod_c[2] * oc
            hc = modulate(rmsnorm(xc, norm_ffn[i]), mod_c[3], mod_c[4])
            tok = jnp.concatenate([hl.reshape(-1, d), hc.reshape(-1, d)], axis=0)
            f = moe_ffn(tok, router_w[i], router_bias[i], exp_w1[i], exp_w3[i], exp_w2[i],
                        sh_w1[i], sh_w3[i], sh_w2[i])
            xl = xl + mod_l[5] * f[:bsz * t].reshape(bsz, t, d)
            xc = xc + mod_c[5] * f[bsz * t:].reshape(xc.shape)
    return rmsnorm(xl, final_norm)
```

```cpp
#include <hip/hip_runtime.h>
#include <cstdio>
#include <cstdint>
#define LAS __attribute__((address_space(3)))
typedef unsigned short bf16_t;
typedef short bf16x8 __attribute__((ext_vector_type(8)));
typedef float f32x2 __attribute__((ext_vector_type(2)));
typedef float f32x4 __attribute__((ext_vector_type(4)));
typedef float f32x16 __attribute__((ext_vector_type(16)));
typedef unsigned u32x2 __attribute__((ext_vector_type(2)));
typedef unsigned u32x4 __attribute__((ext_vector_type(4)));
typedef __bf16 bf16x2_t __attribute__((ext_vector_type(2)));

#ifndef MK_PER_PHASE
#define MK_PER_PHASE 0
#endif

constexpr int D = 1024, NB = 32, SEQ = 2048, CTXL = 256, TPB = SEQ + CTXL  ;
constexpr int MALL = NB * TPB  , MLAT = NB * SEQ  , MCTX = NB * CTXL  ;
constexpr int EVC = 4512, EVP = 4608;
constexpr int C_R = 0, C_K = 512, C_V = 1024, C_XWF = 1536, C_XWB = 1600, C_XAF = 1664, C_XAB = 1728, C_XG = 1792, C_Z = 1920, C_XBC = 2944, C_DT = 4480;
constexpr int MIXD = 1536;
constexpr int NEXP = 64, EFF = 256, CAP = MALL;
constexpr int MLAC = 672, MLAP = 768;
constexpr float NORM_EPS = 1e-6f;

__device__ __forceinline__ unsigned pk2(float lo, float hi) { f32x2 v = {lo, hi}; bf16x2_t b = __builtin_convertvector(v, bf16x2_t); return __builtin_bit_cast(unsigned, b); }
__device__ __forceinline__ bf16_t f2bf(float f) { return (bf16_t)(pk2(f, 0.f) & 0xffffu); }
__device__ __forceinline__ float bf2f(bf16_t b) { return __uint_as_float(((unsigned)b) << 16); }
__device__ __forceinline__ float bflo(unsigned w) { return __uint_as_float(w << 16); }
__device__ __forceinline__ float bfhi(unsigned w) { return __uint_as_float(w & 0xffff0000u); }
#define DPP_ADD(v, ctrl) v += __int_as_float(__builtin_amdgcn_update_dpp(0, __float_as_int(v), ctrl, 0xf, 0xf, true))
__device__ __forceinline__ float rowsum4(float v0, float v1, float v2, float v3) {
    auto s0 = __builtin_amdgcn_permlane32_swap(__float_as_uint(v0), __float_as_uint(v2), false, false); const float c = __uint_as_float(s0[0]) + __uint_as_float(s0[1]);
    auto s1 = __builtin_amdgcn_permlane32_swap(__float_as_uint(v1), __float_as_uint(v3), false, false); const float d = __uint_as_float(s1[0]) + __uint_as_float(s1[1]);
    auto s2 = __builtin_amdgcn_permlane16_swap(__float_as_uint(c), __float_as_uint(d), false, false); float r = __uint_as_float(s2[0]) + __uint_as_float(s2[1]);
    DPP_ADD(r, 0xB1); DPP_ADD(r, 0x4E); DPP_ADD(r, 0x141); DPP_ADD(r, 0x140);
    return r;
}
__device__ __forceinline__ float wave_sum(float v) {
    DPP_ADD(v, 0xB1); DPP_ADD(v, 0x4E); DPP_ADD(v, 0x141); DPP_ADD(v, 0x140);
    const int iv = __float_as_int(v);
    const float r0 = __int_as_float(__builtin_amdgcn_readlane(iv, 0)), r1 = __int_as_float(__builtin_amdgcn_readlane(iv, 16)), r2 = __int_as_float(__builtin_amdgcn_readlane(iv, 32)), r3 = __int_as_float(__builtin_amdgcn_readlane(iv, 48));
    return (r0 + r1) + (r2 + r3);
}
__device__ __forceinline__ float sigmoidf_(float x) { return __builtin_amdgcn_rcpf(1.f + __expf(-x)); }
__device__ __forceinline__ float siluf_(float x) { return x * __builtin_amdgcn_rcpf(1.f + __expf(-x)); }
__device__ __forceinline__ float softplusf_(float x) { return x > 20.f ? x : __logf(1.f + __expf(x)); }
__device__ __forceinline__ float tanhf_(float x) { const float e = __expf(2.f * x); return 1.f - 2.f * __builtin_amdgcn_rcpf(e + 1.f); }
__device__ __forceinline__ void unpack8(const u32x4 w, float (&o)[8]) { o[0] = bflo(w.x); o[1] = bfhi(w.x); o[2] = bflo(w.y); o[3] = bfhi(w.y); o[4] = bflo(w.z); o[5] = bfhi(w.z); o[6] = bflo(w.w); o[7] = bfhi(w.w); }
__device__ __forceinline__ int opaque_s(int x) { asm volatile("" : "+s"(x)); return x; }
__device__ __forceinline__ int opaque(int x) { asm volatile("" : "+v"(x)); return x; }
#define LBAR() asm volatile("s_waitcnt lgkmcnt(0)\n\ts_barrier" ::: "memory")
__device__ __forceinline__ int crow(int r, int hi) { return (r & 3) + 8 * (r >> 2) + 4 * hi; }

#define XB_TMO      128
#define XB_XCNT(j)  (256  + 64 * (j))
#define XB_XSUB(j)  (1280 + 64 * (j))
#define XB_XGEN(j)  (2304 + 64 * (j))
#define XB_TOP      3328
#define XB_TOPGEN   3392
#define XCD_BAR_WORDS 3456
#define XB_SPIN_CAP (1u << 18)
__device__ __forceinline__ unsigned xb_ld(unsigned* p)              { return __hip_atomic_load(p, __ATOMIC_RELAXED, __HIP_MEMORY_SCOPE_AGENT); }
__device__ __forceinline__ unsigned xb_add(unsigned* p, unsigned v) { return __hip_atomic_fetch_add(p, v, __ATOMIC_RELAXED, __HIP_MEMORY_SCOPE_AGENT); }
__device__ __forceinline__ unsigned xb_xcc_id() { return (unsigned)__builtin_amdgcn_s_getreg((3 << 11) | 20) & 0xFu; }
#define XB_SPIN(cond, bar) do { unsigned _sp = 0; while (cond) { __builtin_amdgcn_s_sleep(1); \
    if ((++_sp & 255u) == 0u) { if (xb_ld(&(bar)[XB_TMO])) break; if (_sp > XB_SPIN_CAP) { atomicAdd(&(bar)[XB_TMO], 1u); break; } } } } while (0)
struct XcdBarrier { unsigned* bar; unsigned x; volatile LAS unsigned* st; };
__device__ __forceinline__ XcdBarrier xcd_barrier_post(unsigned* bar, volatile LAS unsigned* st) {
    XcdBarrier b; b.bar = bar; b.x = xb_xcc_id(); b.st = st;
    if (threadIdx.x == 0) (void)xb_add(&bar[XB_XCNT(b.x)], 1u);
    return b;
}
__device__ __forceinline__ void xcd_barrier_complete(unsigned* bar, unsigned x, unsigned& nloc, unsigned& nx) {
    const unsigned G = gridDim.x * gridDim.y * gridDim.z;
    unsigned sum, cnt, mine, sp = 0u;
    for (;;) {
        sum = 0u; cnt = 0u; mine = 0u;
#pragma unroll
        for (unsigned j = 0; j < 16; ++j) { const unsigned c = xb_ld(&bar[XB_XCNT(j)]); sum += c; cnt += (c > 0u) ? 1u : 0u; mine = (j == x) ? c : mine; }
        if (sum == G) break;
        __builtin_amdgcn_s_sleep(1);
        if ((++sp & 255u) == 0u) { if (xb_ld(&bar[XB_TMO])) break; if (sp > XB_SPIN_CAP) { atomicAdd(&bar[XB_TMO], 1u); break; } }
    }
    nloc = mine > 0u ? mine : 1u; nx = cnt > 0u ? cnt : 1u;
}
__device__ __forceinline__ void xcd_barrier(const XcdBarrier& b) {
    asm volatile("s_waitcnt vmcnt(0)" ::: "memory");
    __syncthreads();
    if (threadIdx.x == 0) {
        unsigned* bar = b.bar;
        __builtin_amdgcn_s_waitcnt(0);
        unsigned nloc = b.st[0], nx = b.st[1];
        if (nloc == 0u) { xcd_barrier_complete(bar, b.x, nloc, nx); b.st[0] = nloc; b.st[1] = nx; }
        const unsigned old = xb_add(&bar[XB_XSUB(b.x)], 1u);
        const unsigned gen = old / nloc;
        if (old + 1u == (gen + 1u) * nloc) {
            __builtin_amdgcn_fence(__ATOMIC_RELEASE, "agent");
            asm volatile("s_waitcnt vmcnt(0)" ::: "memory");
            const unsigned og = xb_add(&bar[XB_TOP], 1u);
            const unsigned tg = og / nx;
            if (og + 1u == (tg + 1u) * nx) xb_add(&bar[XB_TOPGEN], 1u);
            else XB_SPIN(xb_ld(&bar[XB_TOPGEN]) == tg, bar);
            __builtin_amdgcn_fence(__ATOMIC_ACQUIRE, "agent");
            xb_add(&bar[XB_XGEN(b.x)], 1u);
            asm volatile("s_waitcnt vmcnt(0)" ::: "memory");
        } else {
            XB_SPIN(xb_ld(&bar[XB_XGEN(b.x)]) == gen, bar);
            __builtin_amdgcn_fence(__ATOMIC_ACQUIRE, "agent");
            asm volatile("s_waitcnt vmcnt(0)" ::: "memory");
        }
    }
    __syncthreads();
}

namespace pg8 {
constexpr int BM = 256, BK = 64, HALF = 128, HTB = HALF * BK * 2, STAGE_BYTES = 8 * HTB, NXCD = 8, WGM = 8;
__host__ __device__ __forceinline__ int lds_byte(int r, int c) { const int st = (r >> 4) * 2 + (c >> 5), rr = r & 15, cc = c & 31, ob = rr * 64 + cc * 2; return st * 1024 + (ob ^ (((ob >> 9) & 1) << 5)); }
__host__ __device__ __forceinline__ void stage_rc(int b, int& R, int& C) { const int st = b / 1024, sb = b % 1024, swz = sb ^ (((sb >> 9) & 1) << 5); R = (st >> 1) * 16 + swz / 64; C = (st & 1) * 32 + (swz % 64) / 2; }
__host__ __device__ __forceinline__ int perm32(int rho) { const int n = rho >> 4, i = rho & 15; return 8 * (i >> 2) + 4 * n + (i & 3); }

struct Unit { int ar, br, cr, cc, e, nv; };
struct Gemm { const bf16_t* A; const bf16_t* Bt; int lda, ldb, K; const int* glist; };

__device__ __forceinline__ bool tile_order(int nM, int nN, long L, int& pm, int& pn) {
    const int nwg = nM * nN; if (L >= nwg) return false;
    int wgid = (int)L; { const int q = nwg / NXCD, r = nwg % NXCD, xcd = wgid % NXCD, off = wgid / NXCD; wgid = (xcd < r ? xcd * (q + 1) : r * (q + 1) + (xcd - r) * q) + off; }
    const int nig = WGM * nN, gid = wgid / nig, fm = gid * WGM, gsz = (nM - fm) < WGM ? (nM - fm) : WGM;
    pm = fm + ((wgid % nig) % gsz); pn = (wgid % nig) / gsz; return true;
}
struct DenseSched {
    int nM, nN, G, c;
    __device__ __forceinline__ void init(int M, int N, int G_, int c_) { nM = M / BM; nN = N / BM; G = G_; c = c_; }
    __device__ __forceinline__ bool next(int i, Unit& u) const {
        int pm, pn; if (!tile_order(nM, nN, (long)i * G + c, pm, pn)) return false;
        u.ar = pm * BM; u.br = pn * BM; u.cr = pm * BM; u.cc = pn * BM; u.e = 0; u.nv = BM; return true;
    }
};

template <class Epi, class Sched, bool GATHER, bool ALIGN_EPI = true, bool SP2 = true>
__device__ __forceinline__ void gemm_phase(LAS unsigned char* lds, const Gemm g, const Sched& S, const Epi& E) {
    const int tid = opaque((int)threadIdx.x), wid = __builtin_amdgcn_readfirstlane(tid >> 6), lane = tid & 63, wr = wid >> 2, wc = wid & 3, fr = lane & 15, fq = lane >> 4;
    const int K = opaque_s(g.K), nt = K / BK;
    unsigned voffA[2], voffBh[2][2];
#pragma unroll
    for (int i = 0; i < 2; ++i) { int R, C; stage_rc(tid * 16 + i * 8192, R, C);
        voffA[i] = (unsigned)(R * g.lda + C) * 2u;
#pragma unroll
        for (int h = 0; h < 2; ++h) { int Rb;
            if (Epi::PERM == 2) Rb = 64 * (R >> 5) + 16 * ((R >> 2) & 3) + 8 * h + 4 * ((R >> 4) & 1) + (R & 3);
            else Rb = h * HALF + (Epi::PERM == 1 ? ((R & ~31) + perm32(R & 31)) : R);
            voffBh[h][i] = (unsigned)(Rb * g.ldb + C) * 2u; } }
    const size_t kstep = (size_t)(BK * 2);
    const size_t hstepA = (size_t)HALF * g.lda * 2;
    const unsigned ldsw = (unsigned)wid * 1024u;
    const int aoff = lds_byte(wr * 64 + fr, fq * 8), boff = lds_byte(wc * 32 + fr, fq * 8);
#define PG8_SA(b, h) (((b) * 2 + (h)) * HTB)
#define PG8_SB(b, h) ((4 + (b) * 2 + (h)) * HTB)
#define PG8_STAGE(bufoff, gbase, voff) do { _Pragma("unroll") for (int _i = 0; _i < 2; ++_i) \
        __builtin_amdgcn_global_load_lds((const unsigned*)((const char*)(gbase) + (voff)[_i]), (LAS unsigned*)(lds + (bufoff) + ldsw + _i * 8192), 16, 0, 0); } while (0)
#define PG8_STAGE_A(bufoff, ubase, h, goffsel) do { if constexpr (GATHER) { PG8_STAGE(bufoff, ubase, (goffsel)[h]); } else { PG8_STAGE(bufoff, (ubase) + (h) * hstepA, voffA); } } while (0)
#define PG8_LDA(dst, b, h) do { _Pragma("unroll") for (int m = 0; m < 4; ++m) _Pragma("unroll") for (int k = 0; k < 2; ++k) dst[m][k] = *(const LAS bf16x8*)(lds + PG8_SA(b, h) + aoff + m * 2048 + k * 1024); } while (0)
#define PG8_LDB(dst, b, h) do { _Pragma("unroll") for (int n = 0; n < 2; ++n) _Pragma("unroll") for (int k = 0; k < 2; ++k) dst[n][k] = *(const LAS bf16x8*)(lds + PG8_SB(b, h) + boff + n * 2048 + k * 1024); } while (0)
#define PG8_MMA(ai, bj, At, Bt) do { __builtin_amdgcn_s_setprio(1); _Pragma("unroll") for (int m = 0; m < 4; ++m) _Pragma("unroll") for (int n = 0; n < 2; ++n) _Pragma("unroll") for (int k = 0; k < 2; ++k) \
        acc[ai][bj][m][n] = __builtin_amdgcn_mfma_f32_16x16x32_bf16(Bt[n][k], At[m][k], acc[ai][bj][m][n], 0, 0, 0); __builtin_amdgcn_s_setprio(0); } while (0)
#define PG8_WAIT_V(n) asm volatile("s_waitcnt vmcnt(" #n ")" ::: "memory")
#define PG8_WAIT_L(n) asm volatile("s_waitcnt lgkmcnt(" #n ")" ::: "memory")
#define PG8_BAR __builtin_amdgcn_s_barrier()
#define PG8_SCHED __builtin_amdgcn_sched_barrier(0)
    Unit cur, nxt; int ui = 0;
    if (!S.next(0, cur)) return;
    f32x4 acc[2][2][4][2];
#pragma unroll
    for (int a = 0; a < 2; ++a)
#pragma unroll
        for (int b = 0; b < 2; ++b)
#pragma unroll
            for (int m = 0; m < 4; ++m)
#pragma unroll
                for (int n = 0; n < 2; ++n) acc[a][b][m][n] = (f32x4){0.f, 0.f, 0.f, 0.f};
    bf16x8 At[4][2], B0[2][2], B1[2][2];
    unsigned gcur[2][2], gnxt[2][2];
#define PG8_GLOAD(dst, u) do { const int _tz = opaque(tid); _Pragma("unroll") for (int _h = 0; _h < 2; ++_h) _Pragma("unroll") for (int _i = 0; _i < 2; ++_i) { int _R0, _C0; stage_rc(_tz * 16 + _i * 8192, _R0, _C0); \
        const int _R = _R0 + _h * HALF; const int _ix = g.glist[(size_t)(u).ar + (_R < (u).nv ? _R : 0)]; dst[_h][_i] = (unsigned)(_ix * g.lda + _C0) * 2u; } } while (0)
    const char* cA; const char* cB = (const char*)g.Bt + (size_t)cur.br * g.ldb * 2;
    if constexpr (GATHER) { cA = (const char*)g.A; PG8_GLOAD(gcur, cur); } else { cA = (const char*)g.A + (size_t)cur.ar * g.lda * 2; }
    if constexpr (SP2) {
        PG8_STAGE(PG8_SB(0, 0), cB, voffBh[0]); PG8_STAGE(PG8_SB(0, 1), cB, voffBh[1]); PG8_STAGE_A(PG8_SA(0, 0), cA, 0, gcur); PG8_STAGE_A(PG8_SA(0, 1), cA, 1, gcur);
        if (wr == 1) PG8_BAR;
        PG8_WAIT_V(2); PG8_BAR;
        PG8_STAGE(PG8_SB(1, 0), cB + kstep, voffBh[0]); PG8_STAGE_A(PG8_SA(1, 0), cA + kstep, 0, gcur); PG8_STAGE(PG8_SB(1, 1), cB + kstep, voffBh[1]);
        PG8_WAIT_V(6); PG8_BAR;
    } else {
    PG8_STAGE(PG8_SB(0, 0), cB, voffBh[0]); PG8_STAGE_A(PG8_SA(0, 0), cA, 0, gcur); PG8_STAGE(PG8_SB(0, 1), cB, voffBh[1]); PG8_STAGE_A(PG8_SA(0, 1), cA, 1, gcur);
    if (wr == 1) PG8_BAR;
    PG8_WAIT_V(4); PG8_BAR;
    PG8_STAGE(PG8_SB(1, 0), cB + kstep, voffBh[0]); PG8_STAGE_A(PG8_SA(1, 0), cA + kstep, 0, gcur); PG8_STAGE(PG8_SB(1, 1), cB + kstep, voffBh[1]);
    PG8_WAIT_V(6); PG8_BAR;
    }
    for (;;) {
        const bool has_next = S.next(ui + 1, nxt);
        const char* nA; const char* nB = has_next ? (const char*)g.Bt + (size_t)nxt.br * g.ldb * 2 : cB;
        if constexpr (GATHER) { nA = cA; if (has_next) { PG8_GLOAD(gnxt, nxt); } else {
#pragma unroll
                for (int _h = 0; _h < 2; ++_h)
#pragma unroll
                    for (int _i = 0; _i < 2; ++_i) gnxt[_h][_i] = gcur[_h][_i]; } }
        else { nA = has_next ? (const char*)g.A + (size_t)nxt.ar * g.lda * 2 : cA; }
        for (int t = 0; t < nt; t += 2) {
            const bool last = (t == nt - 2);
            const char* a1 = cA + (size_t)(t + 1) * kstep;
            const char* a2 = last ? nA : cA + (size_t)(t + 2) * kstep; const char* b2 = last ? nB : cB + (size_t)(t + 2) * kstep;
            const char* a3 = a2 + kstep; const char* b3 = b2 + kstep;
            unsigned g2[2][2];
            if constexpr (GATHER) {
#pragma unroll
                for (int _h = 0; _h < 2; ++_h)
#pragma unroll
                    for (int _i = 0; _i < 2; ++_i) g2[_h][_i] = last ? gnxt[_h][_i] : gcur[_h][_i]; }
            if constexpr (SP2) {
            PG8_LDB(B0, 0, 0); PG8_LDB(B1, 0, 1); PG8_SCHED; PG8_LDA(At, 0, 0); PG8_STAGE_A(PG8_SA(1, 1), a1, 1, gcur);
            PG8_WAIT_V(8); PG8_WAIT_L(0); PG8_BAR; PG8_MMA(0, 0, At, B0); PG8_MMA(0, 1, At, B1); PG8_BAR; PG8_SCHED;
            PG8_LDA(At, 0, 1); PG8_STAGE(PG8_SB(0, 0), b2, voffBh[0]); PG8_STAGE(PG8_SB(0, 1), b2, voffBh[1]); PG8_STAGE_A(PG8_SA(0, 0), a2, 0, g2);
            PG8_WAIT_V(8); PG8_WAIT_L(0); PG8_BAR; PG8_MMA(1, 0, At, B0); PG8_MMA(1, 1, At, B1); PG8_BAR; PG8_SCHED;
            PG8_LDB(B0, 1, 0); PG8_LDB(B1, 1, 1); PG8_SCHED; PG8_LDA(At, 1, 0); PG8_STAGE_A(PG8_SA(0, 1), a2, 1, g2);
            PG8_WAIT_V(8); PG8_WAIT_L(0); PG8_BAR; PG8_MMA(0, 0, At, B0); PG8_MMA(0, 1, At, B1); PG8_BAR; PG8_SCHED;
            PG8_LDA(At, 1, 1); PG8_STAGE(PG8_SB(1, 0), b3, voffBh[0]); PG8_STAGE(PG8_SB(1, 1), b3, voffBh[1]); PG8_STAGE_A(PG8_SA(1, 0), a3, 0, g2);
            PG8_WAIT_V(8); PG8_WAIT_L(0); PG8_BAR; PG8_MMA(1, 0, At, B0); PG8_MMA(1, 1, At, B1); PG8_BAR; PG8_SCHED;
            } else {
            PG8_LDB(B0, 0, 0); PG8_SCHED; PG8_LDA(At, 0, 0); PG8_STAGE_A(PG8_SA(1, 1), a1, 1, gcur);
            PG8_WAIT_L(8); PG8_BAR; PG8_WAIT_L(0); PG8_MMA(0, 0, At, B0); PG8_BAR; PG8_SCHED;
            PG8_LDB(B1, 0, 1); PG8_STAGE(PG8_SB(0, 0), b2, voffBh[0]);
            PG8_BAR; PG8_WAIT_L(0); PG8_MMA(0, 1, At, B1); PG8_BAR;
            PG8_LDA(At, 0, 1); PG8_STAGE_A(PG8_SA(0, 0), a2, 0, g2);
            PG8_BAR; PG8_WAIT_L(0); PG8_MMA(1, 0, At, B0); PG8_BAR; PG8_SCHED;
            PG8_STAGE(PG8_SB(0, 1), b2, voffBh[1]);
            PG8_WAIT_V(6); PG8_BAR; PG8_MMA(1, 1, At, B1); PG8_BAR;
            PG8_LDB(B0, 1, 0); PG8_SCHED; PG8_LDA(At, 1, 0); PG8_STAGE_A(PG8_SA(0, 1), a2, 1, g2);
            PG8_WAIT_L(8); PG8_BAR; PG8_WAIT_L(0); PG8_MMA(0, 0, At, B0); PG8_BAR; PG8_SCHED;
            PG8_LDB(B1, 1, 1); PG8_STAGE(PG8_SB(1, 0), b3, voffBh[0]);
            PG8_BAR; PG8_WAIT_L(0); PG8_MMA(0, 1, At, B1); PG8_BAR;
            PG8_LDA(At, 1, 1); PG8_STAGE_A(PG8_SA(1, 0), a3, 0, g2);
            PG8_BAR; PG8_WAIT_L(0); PG8_MMA(1, 0, At, B0); PG8_BAR; PG8_SCHED;
            PG8_STAGE(PG8_SB(1, 1), b3, voffBh[1]);
            PG8_WAIT_V(6); PG8_BAR; PG8_MMA(1, 1, At, B1); PG8_BAR;
                    }
        }
        if constexpr (ALIGN_EPI) { if (wr == 0) PG8_BAR; }
        E(acc, cur, wr, wc, fr, fq);
        if (!has_next) break;
#pragma unroll
        for (int a = 0; a < 2; ++a)
#pragma unroll
            for (int b = 0; b < 2; ++b)
#pragma unroll
                for (int m = 0; m < 4; ++m)
#pragma unroll
                    for (int n = 0; n < 2; ++n) acc[a][b][m][n] = (f32x4){0.f, 0.f, 0.f, 0.f};
        cur = nxt; cA = nA; cB = nB; ++ui;
        if constexpr (GATHER) {
#pragma unroll
            for (int _h = 0; _h < 2; ++_h)
#pragma unroll
                for (int _i = 0; _i < 2; ++_i) gcur[_h][_i] = gnxt[_h][_i]; }
        if constexpr (ALIGN_EPI) { if (wr == 1) PG8_BAR; }
    }
    PG8_WAIT_V(0);
    if constexpr (!ALIGN_EPI) { if (wr == 0) PG8_BAR; }
    PG8_BAR;
#undef PG8_SA
#undef PG8_SB
#undef PG8_STAGE
#undef PG8_STAGE_A
#undef PG8_LDA
#undef PG8_LDB
#undef PG8_MMA
#undef PG8_WAIT_V
#undef PG8_WAIT_L
#undef PG8_BAR
#undef PG8_SCHED
#undef PG8_GLOAD
}
}

constexpr size_t MiB = 1u << 20;
constexpr size_t WS_CTL = 0, CTL_BYTES = 1 * MiB;
constexpr int CW_BAR = 0, CW_CNT = 4096  , CW_DIAG = 12288;
constexpr size_t WS_MODS = 1 * MiB;
constexpr size_t WS_ROPE = 3 * MiB;
constexpr size_t WS_WIN = 4 * MiB, WS_WOUT = 13 * MiB, WS_WMLA = 16 * MiB, WS_WQ = 18 * MiB, WS_WK = 20 * MiB, WS_WV = 21 * MiB, WS_WO = 22 * MiB;
constexpr size_t WS_ROUT = 24 * MiB  , WS_W2T = 25 * MiB  , WS_A2T = 25 * MiB + 256 * 1024, WS_G2T = 25 * MiB + 512 * 1024  ;
constexpr size_t WS_W13 = 26 * MiB;
constexpr size_t WS_W2E = 156 * MiB;
constexpr size_t WS_BSUM = 221 * MiB;
constexpr size_t WS_COLS = 224 * MiB;
constexpr size_t WS_XL = 224 * MiB, WS_XC = 480 * MiB;
constexpr size_t WS_HID = 512 * MiB;
constexpr size_t WS_LIST = 766 * MiB;
constexpr size_t WS_TSEL = 221 * MiB;
constexpr size_t WS_TGATE = 4 * MiB;
constexpr size_t WS_TOK = 806 * MiB;
constexpr size_t WS_YB = 776 * MiB;
constexpr int YSPLIT = 262144;
constexpr size_t WS_HA1 = 512 * MiB;
constexpr size_t WS_CQN = 728 * MiB, WS_CKVN = 776 * MiB, WS_KR = 832 * MiB;
constexpr size_t WS_Q = 512 * MiB;
constexpr size_t WS_O = 704 * MiB;
constexpr size_t WS_KN = 880 * MiB;
constexpr size_t WS_END = 1024 * MiB;

struct Args { const float* in[42]; float* out; unsigned char* ws; int ph_lo, ph_hi; };

struct Frame {
    LAS unsigned char* lds;
    int tid, lane, wave, G, bid;
    unsigned char* ws; unsigned char* dout;
};

enum { I_X = 0, I_C, I_CTX, I_CCTX, I_ADAW, I_ADAB, I_NMIX, I_NFFN, I_EVWIN, I_EVWOUT, I_RWMU, I_RWW0, I_RWW2, I_RWA0, I_RWA2, I_RWG2, I_RWKK, I_RWKA, I_RWRK, I_RWGNW, I_RWGNB,
       I_CONVW, I_CONVB, I_DTB, I_ALOG, I_SSMD, I_SSMNW, I_MLAWIN, I_MLAQN, I_MLAQUP, I_MLAKVN, I_MLAKVUP, I_MLAWOUT, I_ROUTW, I_ROUTB, I_EW1, I_EW3, I_EW2, I_SW1, I_SW3, I_SW2, I_FNORM };

struct EpiBf16 {
    static constexpr int PERM = 2;
    bf16_t* O; int ldc;
    __device__ __forceinline__ void operator()(const f32x4 (&acc)[2][2][4][2], const pg8::Unit& u, int wr, int wc, int fr, int fq) const {
#pragma unroll
        for (int ai = 0; ai < 2; ++ai)
#pragma unroll
            for (int m = 0; m < 4; ++m) { const int rl = ai * 128 + wr * 64 + m * 16 + fr; if (rl < u.nv) { bf16_t* rowp = O + (size_t)(u.cr + rl) * ldc + u.cc + wc * 64 + 16 * fq;
#pragma unroll
                for (int bj = 0; bj < 2; ++bj) { const f32x4 v0 = acc[ai][bj][m][0], v1 = acc[ai][bj][m][1];
                    u32x4 w; w.x = pk2(v0[0], v0[1]); w.y = pk2(v0[2], v0[3]); w.z = pk2(v1[0], v1[1]); w.w = pk2(v1[2], v1[3]);
                    *(u32x4*)(rowp + bj * 8) = w; } } }
    }
};
struct EpiF32 {
    static constexpr int PERM = 0;
    float* C; int ldc;
    __device__ __forceinline__ void operator()(const f32x4 (&acc)[2][2][4][2], const pg8::Unit& u, int wr, int wc, int fr, int fq) const {
#pragma unroll
        for (int ai = 0; ai < 2; ++ai)
#pragma unroll
            for (int m = 0; m < 4; ++m) { float* rowp = C + (size_t)(u.cr + ai * 128 + wr * 64 + m * 16 + fr) * ldc + u.cc + wc * 32 + 4 * fq;
#pragma unroll
                for (int bj = 0; bj < 2; ++bj)
#pragma unroll
                    for (int n = 0; n < 2; ++n) *(f32x4*)(rowp + bj * 128 + n * 16) = acc[ai][bj][m][n]; }
    }
};
struct EpiGlu {
    static constexpr int PERM = 1;
    bf16_t* H;
    __device__ __forceinline__ void operator()(const f32x4 (&acc)[2][2][4][2], const pg8::Unit& u, int wr, int wc, int fr, int fq) const {
#pragma unroll
        for (int ai = 0; ai < 2; ++ai)
#pragma unroll
            for (int m = 0; m < 4; ++m) { const int rl = ai * 128 + wr * 64 + m * 16 + fr; if (rl < u.nv) {
                float o[8];
#pragma unroll
                for (int n = 0; n < 2; ++n)
#pragma unroll
                    for (int j = 0; j < 4; ++j) { const float a = acc[ai][0][m][n][j], b = acc[ai][1][m][n][j]; o[n * 4 + j] = siluf_(a) * b; }
                u32x4 w; w.x = pk2(o[0], o[1]); w.y = pk2(o[2], o[3]); w.z = pk2(o[4], o[5]); w.w = pk2(o[6], o[7]);
                *(u32x4*)(H + (size_t)(u.cr + rl) * 256 + (u.cc >> 1) + wc * 32 + 8 * fq) = w; } }
    }
};
template <int MODE> struct EpiResid {
    static constexpr int PERM = 0;
    const float* x; const float* ctx; bf16_t* xl; bf16_t* xc; const float* mods;
    __device__ __forceinline__ void operator()(const f32x4 (&acc)[2][2][4][2], const pg8::Unit& u, int wr, int wc, int fr, int fq) const {
        fr = opaque(fr); fq = opaque(fq);
        const float* base = nullptr; bf16_t* out; int mr;
        if (MODE == 0) { const int pm = u.cr >> 8, b = pm / 9, j = pm % 9;
            if (j == 0) { base = ctx + (size_t)(b * CTXL) * D; out = xc + (size_t)(b * CTXL) * D; mr = 32; }
            else { const size_t r0 = (size_t)(b * SEQ + (j - 1) * 256); base = x + r0 * D; out = xl + r0 * D; mr = b; } }
        else { out = xl + (size_t)u.cr * D; mr = u.cr / SEQ; }
        const float* gv = mods + (size_t)mr * 6144 + 2 * D + u.cc + wc * 32 + 4 * fq;
        f32x4 gt[2][2];
#pragma unroll
        for (int bj = 0; bj < 2; ++bj)
#pragma unroll
            for (int n = 0; n < 2; ++n) gt[bj][n] = *(const f32x4*)(gv + bj * 128 + n * 16);
#pragma unroll
        for (int ai = 0; ai < 2; ++ai)
#pragma unroll
            for (int m = 0; m < 4; ++m) { const size_t off = (size_t)(ai * 128 + wr * 64 + m * 16 + fr) * D + u.cc + wc * 32 + 4 * fq;
#pragma unroll
                for (int bj = 0; bj < 2; ++bj)
#pragma unroll
                    for (int n = 0; n < 2; ++n) { f32x4 b4;
                        if (MODE == 0) b4 = *(const f32x4*)(base + off + bj * 128 + n * 16);
                        else { const u32x2 o2 = *(const u32x2*)(out + off + bj * 128 + n * 16); b4 = (f32x4){bflo(o2.x), bfhi(o2.x), bflo(o2.y), bfhi(o2.y)}; }
                        const f32x4 r4 = b4 + gt[bj][n] * acc[ai][bj][m][n]; u32x2 w2; w2.x = pk2(r4[0], r4[1]); w2.y = pk2(r4[2], r4[3]);
                        *(u32x2*)(out + off + bj * 128 + n * 16) = w2; } }
    }
};
struct EpiQ {
    static constexpr int PERM = 0;
    bf16_t* Q; const float* rope;
    __device__ __forceinline__ void operator()(const f32x4 (&acc)[2][2][4][2], const pg8::Unit& u, int wr, int wc, int fr, int fq) const {
        const float qs = 0.10206207261596577f * 1.4426950408889634f;
#pragma unroll
        for (int bj = 0; bj < 2; ++bj) { const int c0 = u.cc + bj * 128 + wc * 32; const bool isr = __builtin_amdgcn_readfirstlane((c0 % 96) == 64);
#pragma unroll
            for (int ai = 0; ai < 2; ++ai)
#pragma unroll
                for (int m = 0; m < 4; ++m) { fr = opaque(fr); fq = opaque(fq); const int row = u.cr + ai * 128 + wr * 64 + m * 16 + fr;
                    f32x4 a = acc[ai][bj][m][0], b = acc[ai][bj][m][1];
                    if (isr) { const int t = row & (SEQ - 1); const f32x4 cs = *(const f32x4*)(rope + t * 16 + 4 * fq), sn = *(const f32x4*)(rope + SEQ * 16 + t * 16 + 4 * fq);
                        const f32x4 a2 = a * cs - b * sn, b2 = a * sn + b * cs; a = a2; b = b2; }
                    a *= qs; b *= qs;
                    bf16_t* p = Q + (size_t)row * 1536 + c0 + 4 * fq;
                    u32x2 w0, w1; w0.x = pk2(a[0], a[1]); w0.y = pk2(a[2], a[3]); w1.x = pk2(b[0], b[1]); w1.y = pk2(b[2], b[3]);
                    *(u32x2*)p = w0; *(u32x2*)(p + 16) = w1; } }
    }
};
constexpr float Y8_SCALE = 64.f, Y8_INV = 1.f / 64.f;
__device__ __forceinline__ unsigned pk4_fp8(float a, float b, float c, float d) {
    a = __builtin_amdgcn_fmed3f(a * Y8_SCALE, -440.f, 440.f); b = __builtin_amdgcn_fmed3f(b * Y8_SCALE, -440.f, 440.f); c = __builtin_amdgcn_fmed3f(c * Y8_SCALE, -440.f, 440.f); d = __builtin_amdgcn_fmed3f(d * Y8_SCALE, -440.f, 440.f);
    int w = __builtin_amdgcn_cvt_pk_fp8_f32(a, b, 0, false); w = __builtin_amdgcn_cvt_pk_fp8_f32(c, d, w, true); return (unsigned)w; }
struct EpiMoeDown {
    static constexpr int PERM = 2;
    unsigned char* ya; unsigned char* yb;
    __device__ __forceinline__ void operator()(const f32x4 (&acc)[2][2][4][2], const pg8::Unit& u, int wr, int wc, int fr, int fq) const {
        fr = opaque(fr); fq = opaque(fq);
        const int cl = u.cc + wc * 64 + 16 * fq;
#pragma unroll
        for (int ai = 0; ai < 2; ++ai)
#pragma unroll
            for (int m = 0; m < 4; ++m) { const int rl = ai * 128 + wr * 64 + m * 16 + fr; if (rl < u.nv) {
                const int row = u.cr + rl;
                unsigned char* rowp = (row < YSPLIT ? ya + (size_t)row * 1024 : yb + (size_t)(row - YSPLIT) * 1024) + cl;
                u32x4 w;
                { const f32x4 a0 = acc[ai][0][m][0], a1 = acc[ai][0][m][1], b0 = acc[ai][1][m][0], b1 = acc[ai][1][m][1];
                  w.x = pk4_fp8(a0[0], a0[1], a0[2], a0[3]); w.y = pk4_fp8(a1[0], a1[1], a1[2], a1[3]); w.z = pk4_fp8(b0[0], b0[1], b0[2], b0[3]); w.w = pk4_fp8(b1[0], b1[1], b1[2], b1[3]); }
                *(u32x4*)rowp = w; } }
    }
};

constexpr int RING_OFF = 0, MISC_OFF = 131072, LDS_BYTES = 147456;
#define LDS_WAIT() asm volatile("s_waitcnt lgkmcnt(0)" ::: "memory")
__device__ __forceinline__ float* ws_f32(const Frame& F, size_t off) { return (float*)(F.ws + off); }
__device__ __forceinline__ bf16_t* ws_bf(const Frame& F, size_t off) { return (bf16_t*)(F.ws + off); }

__device__ __forceinline__ void p0_mods(const Frame& F, const Args& a) {
  for (int cblk = F.bid; cblk < 192; cblk += F.G) {
    LAS float* S = (LAS float*)F.lds;
    for (int i = F.tid; i < 33 * 1024; i += 512) { const int r = i >> 10, d = i & 1023; const float c = (r < 32) ? a.in[I_C][r * 1024 + d] : a.in[I_CCTX][d]; S[i] = siluf_(c); }
    __syncthreads();
    const int col = F.tid & 63, dp = F.tid >> 6, cflat = cblk * 64 + col, layer = cflat / 6144, n = cflat % 6144;
    const float* W = a.in[I_ADAW] + (size_t)layer * 1024 * 6144 + n;
    float acc[33];
#pragma unroll
    for (int r = 0; r < 33; ++r) acc[r] = 0.f;
    for (int d4 = 0; d4 < 32; ++d4) { const int d = dp * 128 + d4 * 4;
        const float w0 = W[(size_t)(d + 0) * 6144], w1 = W[(size_t)(d + 1) * 6144], w2 = W[(size_t)(d + 2) * 6144], w3 = W[(size_t)(d + 3) * 6144];
#pragma unroll
        for (int r = 0; r < 33; ++r) { const f32x4 s4 = *(const LAS f32x4*)(S + r * 1024 + d); acc[r] += s4[0] * w0 + s4[1] * w1 + s4[2] * w2 + s4[3] * w3; } }
    __syncthreads();
    LAS float* Pp = (LAS float*)F.lds;
#pragma unroll
    for (int r = 0; r < 33; ++r) Pp[(dp * 33 + r) * 64 + col] = acc[r];
    __syncthreads();
    float* mods = ws_f32(F, WS_MODS);
    for (int i = F.tid; i < 33 * 64; i += 512) { const int r = i >> 6, c = i & 63; float s = 0.f;
#pragma unroll
        for (int q = 0; q < 8; ++q) s += Pp[(q * 33 + r) * 64 + c];
        const int cf = cblk * 64 + c, ly = cf / 6144, nn = cf % 6144;
        mods[((size_t)ly * 33 + r) * 6144 + nn] = s + a.in[I_ADAB][ly * 6144 + nn]; }
    __syncthreads();
  }
}
__device__ __forceinline__ void conv_item(const float* W, int N, int k0, int n0, bf16_t* dst, int rowbase, int ldd, LAS float* scr, int lane) {
#pragma unroll 8
    for (int i = 0; i < 32; ++i) { const int kk = 2 * i + (lane >> 5); scr[kk * 33 + (lane & 31)] = W[(size_t)(k0 + kk) * N + n0 + (lane & 31)]; }
    LDS_WAIT(); asm volatile("" ::: "memory");
    const int c = lane & 7;
#pragma unroll
    for (int j = 0; j < 4; ++j) { const int n = (lane >> 3) + 8 * j; const LAS float* s = scr + (8 * c) * 33 + n;
        u32x4 o; o.x = pk2(s[0 * 33], s[1 * 33]); o.y = pk2(s[2 * 33], s[3 * 33]); o.z = pk2(s[4 * 33], s[5 * 33]); o.w = pk2(s[6 * 33], s[7 * 33]);
        *(u32x4*)(dst + (size_t)(rowbase + n) * ldd + k0 + 8 * c) = o; }
    LDS_WAIT(); asm volatile("" ::: "memory");
}
template <int MODE> __device__ __forceinline__ void conv_job(const Frame& F, const float* src, int K, int N, size_t sstride, size_t dst_off, size_t dstride_bytes, int ldd, bool expert_batches, int r, LAS float* scr) {
    const int nkb = K / 64, nnb = N / 32, per = nkb * nnb, b = r / per, rr = r % per, kb = rr / nnb, nb = rr % nnb, n0 = nb * 32;
    size_t doff = dst_off;
    if (expert_batches) doff += (size_t)((b >> 6) * 65 + (b & 63)) * dstride_bytes; else doff += (size_t)b * dstride_bytes;
    int rowbase = n0;
    if (MODE == 1 || MODE == 2) rowbase = (n0 >> 7) * 256 + (MODE == 2 ? 128 : 0) + (n0 & 127);
    if (MODE == 3) { const int h = n0 >> 7, j0 = n0 & 127; if (j0 < 64) rowbase = h * 64 + j0; else { rowbase = h * 64 + j0 - 64; doff = WS_WV; } }
    conv_item(src + (size_t)b * sstride, N, kb * 64, n0, (bf16_t*)(F.ws + doff), rowbase, ldd, scr, F.lane);
}
__device__ __forceinline__ void p0_convert(const Frame& F, const Args& a) {
    LAS float* scr = (LAS float*)(F.lds + F.wave * 16384);
    const int gw = F.bid * 8 + F.wave, NGW = F.G * 8;
    constexpr int N0 = 16 * 141, N1 = 24 * 32, N2 = 2 * 16, N3 = 2 * 16, N4 = 2 * 16, N5 = 16 * 21, N6 = 6 * 48, N7 = 4 * 64, N8 = 16 * 32, N9 = 2 * 16 * 2,
                  N10 = 128 * 16 * 8, N12 = 128 * 4 * 32, N13 = 2 * 16 * 8, N15 = 2 * 4 * 32; (void)N10; (void)N12; (void)N13; (void)N15;
    constexpr int NITEMS = N0 + N1 + N2 + N3 + N4 + N5 + N6 + N7 + N8 + N9;
    for (int it = gw; it < NITEMS; it += NGW) {
        int r = it;
        if (r < N0) { conv_job<0>(F, a.in[I_EVWIN], 1024, EVC, 0, WS_WIN, 0, 1024, false, r, scr); continue; } r -= N0;
        if (r < N1) { conv_job<0>(F, a.in[I_EVWOUT], 1536, 1024, 0, WS_WOUT, 0, 1536, false, r, scr); continue; } r -= N1;
        if (r < N2) { conv_job<0>(F, a.in[I_RWW2], 64, 512, 64 * 512, WS_W2T, 512 * 64 * 2, 64, false, r, scr); continue; } r -= N2;
        if (r < N3) { conv_job<0>(F, a.in[I_RWA2], 64, 512, 64 * 512, WS_A2T, 512 * 64 * 2, 64, false, r, scr); continue; } r -= N3;
        if (r < N4) { conv_job<0>(F, a.in[I_RWG2], 128, 512, 0, WS_G2T, 0, 128, false, r, scr); continue; } r -= N4;
        if (r < N5) { conv_job<0>(F, a.in[I_MLAWIN], 1024, MLAC, 0, WS_WMLA, 0, 1024, false, r, scr); continue; } r -= N5;
        if (r < N6) { conv_job<0>(F, a.in[I_MLAQUP], 384, 1536, 0, WS_WQ, 0, 384, false, r, scr); continue; } r -= N6;
        if (r < N7) { conv_job<3>(F, a.in[I_MLAKVUP], 256, 2048, 0, WS_WK, 0, 256, false, r, scr); continue; } r -= N7;
        if (r < N8) { conv_job<0>(F, a.in[I_MLAWOUT], 1024, 1024, 0, WS_WO, 0, 1024, false, r, scr); continue; } r -= N8;
        conv_job<0>(F, a.in[I_ROUTW], 1024, 64, 1024 * 64, WS_ROUT, 64 * 1024 * 2, 1024, false, r, scr);
    }
    const int gt = F.bid * 512 + F.tid, NGT = F.G * 512;
    for (int i = gt; i < 96 * 128; i += NGT) { *(u32x4*)(F.ws + WS_WIN + (size_t)EVC * 2048 + (size_t)i * 16) = (u32x4){0u, 0u, 0u, 0u}; *(u32x4*)(F.ws + WS_WMLA + (size_t)MLAC * 2048 + (size_t)i * 16) = (u32x4){0u, 0u, 0u, 0u}; }
    float* rope = ws_f32(F, WS_ROPE);
    for (int i = gt; i < SEQ * 16; i += NGT) { const int t = i >> 4, k = i & 15; const float idx = (k < 8) ? (float)(t / 64) : (float)(t % 64); const float fr_ = powf(10000.f, -(float)(k & 7) / 8.f);
        const float ang = idx * fr_; rope[i] = cosf(ang); rope[SEQ * 16 + i] = sinf(ang); }
}


constexpr int DRIP_UNITS = 390 * 512;
struct Drip { float v[8]; float v2[8]; int c; };
__device__ __forceinline__ void drip_addr(const Frame& F, const Args& a, int U, int lane, const float*& src, bf16_t*& dst, int& N) {
    const int mat = U >> 9, u = U & 511, t = mat / 130, idx = mat - t * 130, ly = idx / 65, e = idx - ly * 65;
    const float* base = (e < 64) ? a.in[I_EW1 + t] + (size_t)(ly * 64 + e) * 262144 : a.in[I_SW1 + t] + (size_t)ly * 262144;
    if (t < 2) { const int k8 = u >> 2, n = (u & 3) * 64 + lane; N = 256; src = base + (size_t)(k8 * 8) * 256 + n;
        dst = ws_bf(F, WS_W13) + ((size_t)(ly * 65 + e) * 512 + (n >> 7) * 256 + t * 128 + (n & 127)) * 1024 + k8 * 8; }
    else { const int k8 = u >> 4, n = (u & 15) * 64 + lane; N = 1024; src = base + (size_t)(k8 * 8) * 1024 + n;
        dst = ws_bf(F, WS_W2E) + ((size_t)(ly * 65 + e) * 1024 + n) * 256 + k8 * 8; }
}
__device__ __forceinline__ void drip_issue(const Frame& F, const Args& a, Drip& d, int lane) {
    const int U = (2 * d.c) * (F.G * 8) + F.bid * 8 + F.wave, U2 = U + F.G * 8;
    if (U < DRIP_UNITS) { const float* src; bf16_t* dst; int N; drip_addr(F, a, U, lane, src, dst, N);
#pragma unroll
        for (int j = 0; j < 8; ++j) d.v[j] = src[(size_t)j * N]; }
    if (U2 < DRIP_UNITS) { const float* src; bf16_t* dst; int N; drip_addr(F, a, U2, lane, src, dst, N);
#pragma unroll
        for (int j = 0; j < 8; ++j) d.v2[j] = src[(size_t)j * N]; }
}
__device__ __forceinline__ void drip_store(const Frame& F, const Args& a, Drip& d, int lane) {
    const int U = (2 * d.c) * (F.G * 8) + F.bid * 8 + F.wave, U2 = U + F.G * 8;
    if (U < DRIP_UNITS) { const float* src; bf16_t* dst; int N; drip_addr(F, a, U, lane, src, dst, N);
        u32x4 o; o.x = pk2(d.v[0], d.v[1]); o.y = pk2(d.v[2], d.v[3]); o.z = pk2(d.v[4], d.v[5]); o.w = pk2(d.v[6], d.v[7]); *(u32x4*)dst = o; }
    if (U2 < DRIP_UNITS) { const float* src; bf16_t* dst; int N; drip_addr(F, a, U2, lane, src, dst, N);
        u32x4 o; o.x = pk2(d.v2[0], d.v2[1]); o.y = pk2(d.v2[2], d.v2[3]); o.z = pk2(d.v2[4], d.v2[5]); o.w = pk2(d.v2[6], d.v2[7]); *(u32x4*)dst = o; }
    ++d.c;
}

__device__ __forceinline__ void norm_mod_row(const float* src, const float* gw, const float* shift, const float* scale, bf16_t* dst, int lane) {
    f32x4 v[4]; float ss = 0.f;
#pragma unroll
    for (int j = 0; j < 4; ++j) { v[j] = *(const f32x4*)(src + 4 * lane + 256 * j); ss += v[j][0] * v[j][0] + v[j][1] * v[j][1] + v[j][2] * v[j][2] + v[j][3] * v[j][3]; }
    const float rs = rsqrtf(wave_sum(ss) * (1.f / D) + NORM_EPS);
#pragma unroll
    for (int j = 0; j < 4; ++j) { const int c = 4 * lane + 256 * j; const f32x4 g4 = *(const f32x4*)(gw + c), sh = *(const f32x4*)(shift + c), sc = *(const f32x4*)(scale + c);
        const f32x4 o = (v[j] * rs * g4) * (1.f + sc) + sh;
        u32x2 w; w.x = pk2(o[0], o[1]); w.y = pk2(o[2], o[3]); *(u32x2*)(dst + c) = w; }
}
__device__ __forceinline__ const float* resid_row(const float* lat, const float* ctxp, int g, int& modrow) {
    const int b = g / TPB, p = g - b * TPB;
    if (p < CTXL) { modrow = 32; return ctxp + (size_t)(b * CTXL + p) * D; }
    modrow = b; return lat + (size_t)(b * SEQ + p - CTXL) * D;
}
__device__ __forceinline__ const bf16_t* resid_row_bf(const bf16_t* lat, const bf16_t* ctxp, int g, int& modrow) {
    const int b = g / TPB, p = g - b * TPB;
    if (p < CTXL) { modrow = 32; return ctxp + (size_t)(b * CTXL + p) * D; }
    modrow = b; return lat + (size_t)(b * SEQ + p - CTXL) * D;
}
__device__ __forceinline__ void rows4_bf_load(const bf16_t* const (&src)[4], u32x4 (&raw)[4][2], int lane) {
#pragma unroll
    for (int r = 0; r < 4; ++r)
#pragma unroll
        for (int j = 0; j < 2; ++j) raw[r][j] = *(const u32x4*)(src[r] + 8 * lane + 512 * j);
}
__device__ __forceinline__ void rows4_bf_finish(const u32x4 (&raw)[4][2], const float* gw, const float* const (&mv)[4], bf16_t* const (&dst)[4], int lane) {
    float ss[4];
#pragma unroll
    for (int r = 0; r < 4; ++r) { float s = 0.f;
#pragma unroll
        for (int j = 0; j < 2; ++j) { float v[8]; unpack8(raw[r][j], v);
#pragma unroll
            for (int c = 0; c < 8; ++c) s += v[c] * v[c]; }
        ss[r] = s; }
#pragma unroll
    for (int r = 0; r < 4; ++r) ss[r] = rsqrtf(wave_sum(ss[r]) * (1.f / D) + NORM_EPS);
#pragma unroll
    for (int j = 0; j < 2; ++j) { const int c0 = 8 * lane + 512 * j; const f32x4 g0 = *(const f32x4*)(gw + c0), g1 = *(const f32x4*)(gw + c0 + 4);
#pragma unroll
        for (int r = 0; r < 4; ++r) { float v[8]; unpack8(raw[r][j], v);
            const f32x4 sh0 = *(const f32x4*)(mv[r] + c0), sh1 = *(const f32x4*)(mv[r] + c0 + 4), sc0 = *(const f32x4*)(mv[r] + D + c0), sc1 = *(const f32x4*)(mv[r] + D + c0 + 4);
            const f32x4 o0 = ((f32x4){v[0], v[1], v[2], v[3]} * ss[r] * g0) * (1.f + sc0) + sh0, o1 = ((f32x4){v[4], v[5], v[6], v[7]} * ss[r] * g1) * (1.f + sc1) + sh1;
            u32x4 w; w.x = pk2(o0[0], o0[1]); w.y = pk2(o0[2], o0[3]); w.z = pk2(o1[0], o1[1]); w.w = pk2(o1[2], o1[3]); *(u32x4*)(dst[r] + c0) = w; } }
}
__device__ __forceinline__ void norm_mod_rows4_bf(const bf16_t* const (&src)[4], const float* gw, const float* const (&mv)[4], bf16_t* const (&dst)[4], int lane) {
    u32x4 raw[4][2]; rows4_bf_load(src, raw, lane); rows4_bf_finish(raw, gw, mv, dst, lane);
}
__device__ __forceinline__ void norm_mod_rows4(const float* const (&src)[4], const float* gw, const float* const (&mv)[4], bf16_t* const (&dst)[4], int lane) {
    f32x4 v[4][4]; float ss[4];
#pragma unroll
    for (int r = 0; r < 4; ++r)
#pragma unroll
        for (int j = 0; j < 4; ++j) v[r][j] = *(const f32x4*)(src[r] + 4 * lane + 256 * j);
#pragma unroll
    for (int r = 0; r < 4; ++r) { float s = 0.f;
#pragma unroll
        for (int j = 0; j < 4; ++j) s += v[r][j][0] * v[r][j][0] + v[r][j][1] * v[r][j][1] + v[r][j][2] * v[r][j][2] + v[r][j][3] * v[r][j][3];
        ss[r] = s; }
#pragma unroll
    for (int r = 0; r < 4; ++r) ss[r] = rsqrtf(wave_sum(ss[r]) * (1.f / D) + NORM_EPS);
#pragma unroll
    for (int j = 0; j < 4; ++j) { const int c = 4 * lane + 256 * j; const f32x4 g4 = *(const f32x4*)(gw + c);
#pragma unroll
        for (int r = 0; r < 4; ++r) { const f32x4 sh = *(const f32x4*)(mv[r] + c), sc = *(const f32x4*)(mv[r] + D + c);
            const f32x4 o = (v[r][j] * ss[r] * g4) * (1.f + sc) + sh;
            u32x2 w; w.x = pk2(o[0], o[1]); w.y = pk2(o[2], o[3]); *(u32x2*)(dst[r] + c) = w; } }
}
__device__ __forceinline__ void p_normmod(const Frame& F, const float* lat, const float* ctxp, const float* gw, const float* mods, int chunk, bf16_t* dst) {
    const int gw_ = F.bid * 8 + F.wave, NGW = F.G * 8;
    for (int g = gw_; g < MALL; g += 4 * NGW) { const float* src[4]; const float* mv[4]; bf16_t* dp[4];
#pragma unroll
        for (int r = 0; r < 4; ++r) { int mr; const int gg = g + r * NGW < MALL ? g + r * NGW : g; src[r] = resid_row(lat, ctxp, gg, mr); mv[r] = mods + (size_t)mr * 6144 + chunk * D; dp[r] = dst + (size_t)gg * D; }
        norm_mod_rows4(src, gw, mv, dp, F.lane); }
}

struct L64  { LAS unsigned char* p; __device__ __forceinline__ bf16x8 get(int row, int g) const { return *(const LAS bf16x8*)(p + row * 128 + ((g ^ (row & 7) ^ ((row >> 3) & 7)) << 4)); } };
struct L128 { LAS unsigned char* p; __device__ __forceinline__ bf16x8 get(int row, int g) const { return *(const LAS bf16x8*)(p + row * 256 + ((g ^ (row & 15)) << 4)); } };
struct GM   { const bf16_t* p; int ld; __device__ __forceinline__ bf16x8 get(int row, int g) const { return *(const bf16x8*)(p + (size_t)row * ld + g * 8); } };
__device__ __forceinline__ int sw64(int r, int c) { return r * 128 + ((((c) >> 3) ^ (r & 7) ^ ((r >> 3) & 7)) << 4) + ((c) & 7) * 2; }
__device__ __forceinline__ int sw128(int r, int c) { return r * 256 + ((((c) >> 3) ^ (r & 15)) << 4) + ((c) & 7) * 2; }
template <int KS, class OA, class OB>
__device__ __forceinline__ void mm32(f32x16& acc, const OA& a, int ar0, int ag0, const OB& b, int br0, int bg0, int lane) {
    const int r = lane & 31, h = lane >> 5;
#pragma unroll KS <= 8 ? KS : 4
    for (int s = 0; s < KS; ++s) { const bf16x8 av = a.get(ar0 + r, ag0 + 2 * s + h), bv = b.get(br0 + r, bg0 + 2 * s + h);
        acc = __builtin_amdgcn_mfma_f32_32x32x16_bf16(av, bv, acc, 0, 0, 0); }
}
__device__ __forceinline__ void stT64(const f32x16& acc, LAS unsigned char* X, int n0, int m0, int lane) {
    const int n = n0 + (lane & 31), h = lane >> 5;
#pragma unroll
    for (int g = 0; g < 4; ++g) { u32x2 w; w.x = pk2(acc[4 * g], acc[4 * g + 1]); w.y = pk2(acc[4 * g + 2], acc[4 * g + 3]); *(LAS u32x2*)(X + sw64(n, m0 + 8 * g + 4 * h)) = w; }
}
__device__ __forceinline__ void stT128(const f32x16& acc, LAS unsigned char* X, int n0, int m0, int lane) {
    const int n = n0 + (lane & 31), h = lane >> 5;
#pragma unroll
    for (int g = 0; g < 4; ++g) { u32x2 w; w.x = pk2(acc[4 * g], acc[4 * g + 1]); w.y = pk2(acc[4 * g + 2], acc[4 * g + 3]); *(LAS u32x2*)(X + sw128(n, m0 + 8 * g + 4 * h)) = w; }
}
#define ZERO16 (f32x16){0.f,0.f,0.f,0.f,0.f,0.f,0.f,0.f,0.f,0.f,0.f,0.f,0.f,0.f,0.f,0.f}

constexpr int SLOT = 8192;
enum { S_AT = 0, S_RT, S_KT, S_BT, S_VT, S_KH, S_BH, S_SB, S_MK, S_NK, S_NB, S_L, S_LT, S_XA, S_QA, S_QTA };
constexpr int S_RHS = S_KT, S_XB = S_BT, S_QB = S_AT, S_QTB = S_MK, S_U = S_QA, S_SG = S_L  , S_XW = S_XA, S_XAA = S_QA;
constexpr int WPRE_OFF = S_MK * SLOT;
__device__ __forceinline__ void rwkv_task(const Frame& F, const Args& a, int task) {
    const int b = task >> 3, h = task & 7, lane0 = F.lane, w = F.wave; int lane = lane0, tid = F.tid;
    LAS unsigned char* L = F.lds;
    LAS float* misc = (LAS float*)(F.lds + MISC_OFF);
    const bf16_t* cols = ws_bf(F, WS_COLS);
    bf16_t* mixin = (bf16_t*)F.dout;
    float* bsumg = ws_f32(F, WS_BSUM);
    int hc = h * 64 + lane;
    const float mu_r = a.in[I_RWMU][hc], mu_k = a.in[I_RWMU][512 + hc], mu_v = a.in[I_RWMU][1024 + hc];
    const float kkp = a.in[I_RWKK][hc], kap = a.in[I_RWKA][hc], rkp = a.in[I_RWRK][hc];
#define SL(s) (L + (s) * SLOT)
    if (tid < 64) { misc[640 + tid] = a.in[I_RWGNW][h * 64 + tid]; misc[704 + tid] = a.in[I_RWGNB][h * 64 + tid]; }
    for (int dir = 0; dir < 2; ++dir) {
        const float w0p = a.in[I_RWW0][dir * 512 + hc], a0p = a.in[I_RWA0][dir * 512 + hc];
        const GM w2g{ws_bf(F, WS_W2T) + (size_t)(dir * 512 + h * 64) * 64, 64}, a2g{ws_bf(F, WS_A2T) + (size_t)(dir * 512 + h * 64) * 64, 64};
        if (tid < 64) { misc[768 + tid] = a.in[I_RWMU][(dir ? C_XWB : C_XWF) + tid]; misc[832 + tid] = a.in[I_RWMU][(dir ? C_XAB : C_XAF) + tid]; misc[896 + tid] = a.in[I_RWMU][C_XG + tid]; misc[960 + tid] = a.in[I_RWMU][C_XG + 64 + tid]; }
        bf16x8 wfr[4];
        { const GM& wsrc = (w >> 2) ? a2g : w2g;
#pragma unroll
          for (int s = 0; s < 4; ++s) wfr[s] = wsrc.get(((w >> 1) & 1) * 32 + (lane0 & 31), 2 * s + (lane0 >> 5)); }
        f32x16 sreg = ZERO16;
        for (int i = tid; i < SLOT / 4; i += 512) ((LAS unsigned*)SL(S_SB))[i] = 0u;
        __syncthreads();
        for (int seg = 0; seg < 2; ++seg) {
            const int len = seg ? SEQ : CTXL, g0 = b * TPB + (seg ? CTXL : 0);
            for (int c0 = 0; c0 < len; c0 += 64) {
#define POS(s) (dir ? (len - 1 - (c0 + (s))) : (c0 + (s)))
                lane = opaque(lane0); tid = w * 64 + lane; hc = h * 64 + lane;
                { const int tk = tid >> 3, c8 = (tid & 7) * 8;
                  float cw[3][8], ca[3][8];
#pragma unroll
                  for (int q = 0; q < 3; ++q) { const int s = tk - 1 + q, ps = POS(s); const bool ok = (s >= -c0) && (c0 + s < len);
                      const int pcl = ps < 0 ? 0 : (ps >= len ? len - 1 : ps); const bf16_t* rp = cols + (size_t)(g0 + pcl) * EVP;
                      u32x4 vw = *(const u32x4*)(rp + (dir ? C_XWB : C_XWF) + c8), va = *(const u32x4*)(rp + (dir ? C_XAB : C_XAF) + c8);
                      if (!ok) { vw = (u32x4){0u, 0u, 0u, 0u}; va = vw; }
                      unpack8(vw, cw[q]); unpack8(va, ca[q]); }
                  float ow[8], oa[8];
                  float muw[8], mua[8]; { const f32x4 m0 = *(const LAS f32x4*)(misc + 768 + c8), m1 = *(const LAS f32x4*)(misc + 772 + c8), m2 = *(const LAS f32x4*)(misc + 832 + c8), m3 = *(const LAS f32x4*)(misc + 836 + c8);
#pragma unroll
                      for (int j = 0; j < 4; ++j) { muw[j] = m0[j]; muw[4 + j] = m1[j]; mua[j] = m2[j]; mua[4 + j] = m3[j]; } }
#pragma unroll
                  for (int j = 0; j < 8; ++j) {
                      ow[j] = tanhf_(cw[1][j] + muw[j] * (0.5f * (cw[0][j] + cw[2][j]) - cw[1][j])); oa[j] = ca[1][j] + mua[j] * (0.5f * (ca[0][j] + ca[2][j]) - ca[1][j]); }
                  u32x4 pw, pa; pw.x = pk2(ow[0], ow[1]); pw.y = pk2(ow[2], ow[3]); pw.z = pk2(ow[4], ow[5]); pw.w = pk2(ow[6], ow[7]);
                  pa.x = pk2(oa[0], oa[1]); pa.y = pk2(oa[2], oa[3]); pa.z = pk2(oa[4], oa[5]); pa.w = pk2(oa[6], oa[7]);
                  *(LAS u32x4*)(SL(S_XW) + sw64(tk, c8)) = pw; *(LAS u32x4*)(SL(S_XAA) + sw64(tk, c8)) = pa; }
                LBAR();
                lane = opaque(lane0); tid = w * 64 + lane; hc = h * 64 + lane;
                { const int mat = w >> 2, tm = (w >> 1) & 1, tn = w & 1; f32x16 acc = ZERO16;
                  const L64 xin{SL(mat ? S_XAA : S_XW)};
#pragma unroll
                  for (int s = 0; s < 4; ++s) acc = __builtin_amdgcn_mfma_f32_32x32x16_bf16(wfr[s], xin.get(tn * 32 + (lane & 31), 2 * s + (lane >> 5)), acc, 0, 0, 0);
                  LAS float* wp = (LAS float*)(L + WPRE_OFF) + (mat * 64 + tn * 32 + (lane & 31)) * 68 + tm * 32 + 4 * (lane >> 5);
#pragma unroll
                  for (int g = 0; g < 4; ++g) *(LAS f32x4*)(wp + 8 * g) = (f32x4){acc[4 * g], acc[4 * g + 1], acc[4 * g + 2], acc[4 * g + 3]}; }
                LBAR();
                lane = opaque(lane0); tid = w * 64 + lane; hc = h * 64 + lane;
                { float rr[10], kr[10], vr[10];
#pragma unroll
                  for (int q = 0; q < 10; ++q) { const int s = 8 * w - 1 + q, ps = POS(s); const bool ok = (c0 + s >= 0) && (c0 + s < len);
                      const int pcl = ps < 0 ? 0 : (ps >= len ? len - 1 : ps); const bf16_t* rp = cols + (size_t)(g0 + pcl) * EVP + hc;
                      float x0 = bf2f(rp[C_R]), x1 = bf2f(rp[C_K]), x2 = bf2f(rp[C_V]); if (!ok) { x0 = 0.f; x1 = 0.f; x2 = 0.f; }
                      rr[q] = x0; kr[q] = x1; vr[q] = x2; }
                  float lw[8], kd[8], bb[8], kk[8], rv[8], vv[8], pn[8], pb[8];
                  const int jl = lane >> 4;
                  const float bpA = dir ? __builtin_nontemporal_load(bsumg + (size_t)(g0 + POS(8 * w + jl)) * 8 + h) : 0.f, bpB = dir ? __builtin_nontemporal_load(bsumg + (size_t)(g0 + POS(8 * w + 4 + jl)) * 8 + h) : 0.f;
                  const LAS float* wpw = (const LAS float*)(L + WPRE_OFF), *wpa = wpw + 64 * 68;
#pragma unroll
                  for (int j = 0; j < 8; ++j) { const int i = 8 * w + j;
                      const float r_ = rr[j + 1] + mu_r * (0.5f * (rr[j] + rr[j + 2]) - rr[j + 1]);
                      const float k_ = kr[j + 1] + mu_k * (0.5f * (kr[j] + kr[j + 2]) - kr[j + 1]);
                      const float v_ = vr[j + 1] + mu_v * (0.5f * (vr[j] + vr[j + 2]) - vr[j + 1]);
                      const float kq = k_ * kkp; kk[j] = kq; pn[j] = kq * kq;
                      const float wpre = w0p + wpw[i * 68 + lane], apre = a0p + wpa[i * 68 + lane];
                      const float wlog = -softplusf_(-wpre) - 0.5f; lw[j] = -__expf(wlog);
                      const float av = sigmoidf_(apre);
                      kd[j] = k_ * (1.f + (av - 1.f) * kap); bb[j] = av; rv[j] = r_; vv[j] = v_;
                      pb[j] = r_ * kd[j] * rkp; }
                  { const float n0 = rowsum4(pn[0], pn[1], pn[2], pn[3]), n1 = rowsum4(pn[4], pn[5], pn[6], pn[7]);
                    const float s0 = rowsum4(pb[0], pb[1], pb[2], pb[3]), s1 = rowsum4(pb[4], pb[5], pb[6], pb[7]);
#pragma unroll
                    for (int j = 0; j < 8; ++j) { const float n2 = __int_as_float(__builtin_amdgcn_readlane(__float_as_int(j < 4 ? n0 : n1), 16 * (j & 3)));
                        const float kkn = kk[j] * rsqrtf(n2 + 1e-12f); kk[j] = kkn; bb[j] = kkn * bb[j]; }
                    if ((lane & 15) == 0) { const int iA = 8 * w + jl, iB = iA + 4;
                        if (!dir) { bsumg[(size_t)(g0 + POS(iA)) * 8 + h] = s0; bsumg[(size_t)(g0 + POS(iB)) * 8 + h] = s1; }
                        misc[576 + iA] = s0 + bpA; misc[576 + iB] = s1 + bpB; } }
                  float cl[8]; cl[0] = lw[0];
#pragma unroll
                  for (int j = 1; j < 8; ++j) cl[j] = cl[j - 1] + lw[j];
                  misc[64 + w * 64 + lane] = cl[7];
                  LBAR();
                  float off = 0.f, tot = 0.f;
#pragma unroll
                  for (int o = 0; o < 8; ++o) { const float t = misc[64 + o * 64 + lane]; tot += t; if (o < w) off += t; }
                  if (w == 0) misc[lane] = __expf(tot);
                  float oKH[8], oBH[8];
#pragma unroll
                  for (int j = 0; j < 8; ++j) { const int i = 8 * w + j; const float cum = off + cl[j]; const float Pi = __expf(cum), Pm1 = __expf(cum - lw[j]), iP = __expf(-cum), PCr = __expf(tot - cum);
                      *(LAS bf16_t*)(SL(S_AT) + sw64(i, lane)) = f2bf(kk[j] * Pm1); *(LAS bf16_t*)(SL(S_RT) + sw64(i, lane)) = f2bf(rv[j] * Pi);
                      *(LAS bf16_t*)(SL(S_KT) + sw64(i, lane)) = f2bf(kd[j] * iP); *(LAS bf16_t*)(SL(S_BT) + sw64(i, lane)) = f2bf(bb[j] * iP);
                      oKH[j] = kd[j] * PCr; oBH[j] = -bb[j] * PCr; }
                  u32x4 t;
                  t.x = pk2(oKH[0], oKH[1]); t.y = pk2(oKH[2], oKH[3]); t.z = pk2(oKH[4], oKH[5]); t.w = pk2(oKH[6], oKH[7]); *(LAS u32x4*)(SL(S_KH) + sw64(lane, 8 * w)) = t;
                  t.x = pk2(oBH[0], oBH[1]); t.y = pk2(oBH[2], oBH[3]); t.z = pk2(oBH[4], oBH[5]); t.w = pk2(oBH[6], oBH[7]); *(LAS u32x4*)(SL(S_BH) + sw64(lane, 8 * w)) = t;
                  t.x = pk2(vv[0], vv[1]); t.y = pk2(vv[2], vv[3]); t.z = pk2(vv[4], vv[5]); t.w = pk2(vv[6], vv[7]); *(LAS u32x4*)(SL(S_VT) + sw64(lane, 8 * w)) = t; }
                LBAR();
                lane = opaque(lane0); tid = w * 64 + lane; hc = h * 64 + lane;
                f32x16 xf = ZERO16;
                unsigned pf = 0u;
                if (c0 + 64 < len && (dir || w < 5)) { const int sn = c0 + 64 + (w == 7 ? lane : ((c0 + 65 + lane < len) ? 1 + lane : 0)), pn = dir ? (len - 1 - sn) : sn;
                    const int coff = w == 0 ? (dir ? C_XWB : C_XWF) : w == 1 ? (dir ? C_XAB : C_XAF) : w == 2 ? C_R + h * 64 : w == 3 ? C_K + h * 64 : w == 4 ? C_V + h * 64 : w == 5 ? C_XG : C_XG + 64;
                    const bf16_t* pp = (w == 7) ? mixin + (size_t)(g0 + pn) * MIXD + h * 64 : cols + (size_t)(g0 + pn) * EVP + coff;
                    pf = *(const unsigned*)pp; }
                const int ti = (w >> 1) & 1, tj = w & 1;
                { const L64 AT{SL(S_AT)}, RT{SL(S_RT)}, KT{SL(S_KT)}, BT{SL(S_BT)};
                  const int i = ti * 32 + (lane & 31), hh = lane >> 5;
                  if (w < 4) {
                      f32x16 l_ = ZERO16, nk = ZERO16;
                      if (tj <= ti) { mm32<4>(l_, BT, tj * 32, 0, AT, ti * 32, 0, lane); mm32<4>(nk, KT, tj * 32, 0, RT, ti * 32, 0, lane); }
#pragma unroll
                      for (int r = 0; r < 16; ++r) { const int j = tj * 32 + crow(r, hh); l_[r] = (j < i) ? l_[r] : 0.f; nk[r] = (j <= i) ? nk[r] : 0.f; xf[r] = ((j == i) ? 1.f : 0.f) - l_[r]; }
                      stT64(l_, SL(S_L), ti * 32, tj * 32, lane); stT64(nk, SL(S_NK), ti * 32, tj * 32, lane); stT64(xf, SL(S_XA), ti * 32, tj * 32, lane);
                  } else {
                      f32x16 mk = ZERO16, nb = ZERO16, lt = ZERO16;
                      if (tj <= ti) { mm32<4>(mk, KT, tj * 32, 0, AT, ti * 32, 0, lane); mm32<4>(nb, BT, tj * 32, 0, RT, ti * 32, 0, lane); }
#pragma unroll
                      for (int r = 0; r < 16; ++r) { const int j = tj * 32 + crow(r, hh); mk[r] = (j < i) ? mk[r] : 0.f; nb[r] = (j <= i) ? -nb[r] : 0.f; }
                      stT64(mk, SL(S_MK), ti * 32, tj * 32, lane); stT64(nb, SL(S_NB), ti * 32, tj * 32, lane);
                      const int jl = ti * 32 + (lane & 31);
                      if (ti <= tj) mm32<4>(lt, AT, tj * 32, 0, BT, ti * 32, 0, lane);
#pragma unroll
                      for (int r = 0; r < 16; ++r) { const int ii = tj * 32 + crow(r, hh); lt[r] = (jl < ii) ? lt[r] : 0.f; }
                      stT64(lt, SL(S_LT), ti * 32, tj * 32, lane);
                  } }
                LBAR();
                lane = opaque(lane0); tid = w * 64 + lane; hc = h * 64 + lane;
                { const L64 Lm{SL(S_L)}, LTm{SL(S_LT)};
                  if (w < 4) { f32x16 q = ZERO16, qt = ZERO16;
                      mm32<4>(q, LTm, tj * 32, 0, Lm, ti * 32, 0, lane);   stT64(q, SL(S_QA), ti * 32, tj * 32, lane);
                      mm32<4>(qt, Lm, tj * 32, 0, LTm, ti * 32, 0, lane);  stT64(qt, SL(S_QTA), ti * 32, tj * 32, lane);
                  } else { f32x16 rh = ZERO16; const L64 AT{SL(S_AT)}, SB{SL(S_SB)}, MK{SL(S_MK)}, VT{SL(S_VT)};
                      mm32<4>(rh, AT, tj * 32, 0, SB, ti * 32, 0, lane); mm32<4>(rh, MK, tj * 32, 0, VT, ti * 32, 0, lane);
                      stT64(rh, SL(S_RHS), ti * 32, tj * 32, lane); } }
                LBAR();
                lane = opaque(lane0); tid = w * 64 + lane; hc = h * 64 + lane;
#pragma unroll
                for (int it = 0; it < 4; ++it) { const bool fromA = (it & 1) == 0; lane = opaque(lane0);
                    const L64 Xs{SL(fromA ? S_XA : S_XB)}, Qs{SL(fromA ? S_QA : S_QB)}, QTs{SL(fromA ? S_QTA : S_QTB)};
                    LAS unsigned char* Xd = SL(fromA ? S_XB : S_XA); LAS unsigned char* Qd = SL(fromA ? S_QB : S_QA); LAS unsigned char* QTd = SL(fromA ? S_QTB : S_QTA);
                    if (w < 4) { mm32<4>(xf, QTs, tj * 32, 0, Xs, ti * 32, 0, lane); stT64(xf, Xd, ti * 32, tj * 32, lane); }
                    else { f32x16 q = ZERO16, qt = ZERO16;
                        mm32<4>(q, QTs, tj * 32, 0, Qs, ti * 32, 0, lane); stT64(q, Qd, ti * 32, tj * 32, lane);
                        mm32<4>(qt, Qs, tj * 32, 0, QTs, ti * 32, 0, lane); stT64(qt, QTd, ti * 32, tj * 32, lane); }
                    LBAR(); }
                lane = opaque(lane0); tid = w * 64 + lane; hc = h * 64 + lane;
                if (w < 4) { const L64 Xs{SL(S_XA)}, QTs{SL(S_QTA)}; mm32<4>(xf, QTs, tj * 32, 0, Xs, ti * 32, 0, lane); stT64(xf, SL(S_XB), ti * 32, tj * 32, lane); }
                else if (dir) {
#pragma unroll
                    for (int it = 0; it < 4; ++it) { const int item = (tid - 256) + it * 256, tk = item >> 4, c8 = (item & 15) * 8;
                        float cg[3][8];
#pragma unroll
                        for (int q = 0; q < 3; ++q) { const int s = tk - 1 + q, ps = POS(s); const bool ok = (c0 + s >= 0) && (c0 + s < len); const int pcl = ps < 0 ? 0 : (ps >= len ? len - 1 : ps);
                            u32x4 vg = *(const u32x4*)(cols + (size_t)(g0 + pcl) * EVP + C_XG + c8); if (!ok) vg = (u32x4){0u, 0u, 0u, 0u}; unpack8(vg, cg[q]); }
                        float og[8];
                        const f32x4 mg0 = *(const LAS f32x4*)(misc + 896 + c8), mg1 = *(const LAS f32x4*)(misc + 900 + c8);
#pragma unroll
                        for (int j = 0; j < 8; ++j) { const float mug = j < 4 ? mg0[j & 3] : mg1[j & 3]; og[j] = sigmoidf_(cg[1][j] + mug * (0.5f * (cg[0][j] + cg[2][j]) - cg[1][j])); }
                        u32x4 pg; pg.x = pk2(og[0], og[1]); pg.y = pk2(og[2], og[3]); pg.z = pk2(og[4], og[5]); pg.w = pk2(og[6], og[7]);
                        *(LAS u32x4*)(SL(S_SG) + sw128(tk, c8)) = pg; } }
                LBAR();
                lane = opaque(lane0); tid = w * 64 + lane; hc = h * 64 + lane;
                if (w < 4) { f32x16 u = ZERO16; const L64 Z{SL(S_XB)}, RH{SL(S_RHS)};
                    mm32<4>(u, Z, tj * 32, 0, RH, ti * 32, 0, lane);
                    stT64(u, SL(S_U), ti * 32, tj * 32, lane); }
                LBAR();
                lane = opaque(lane0); tid = w * 64 + lane; hc = h * 64 + lane;
                { const L64 SB{SL(S_SB)}, VT{SL(S_VT)}, U{SL(S_U)}, RT{SL(S_RT)}, NK{SL(S_NK)}, NB{SL(S_NB)}, KH{SL(S_KH)}, BH{SL(S_BH)};
                  if (w < 2) {
                      f32x16 y0 = ZERO16, y1 = ZERO16;
                      mm32<4>(y0, SB, 0, 0, RT, w * 32, 0, lane);  mm32<4>(y0, VT, 0, 0, NK, w * 32, 0, lane);  mm32<4>(y0, U, 0, 0, NB, w * 32, 0, lane);
                      mm32<4>(y1, SB, 32, 0, RT, w * 32, 0, lane); mm32<4>(y1, VT, 32, 0, NK, w * 32, 0, lane); mm32<4>(y1, U, 32, 0, NB, w * 32, 0, lane);
                      const int i = w * 32 + (lane & 31), hh = lane >> 5; const size_t grow = (size_t)(g0 + POS(i));
                      bf16_t* op = mixin + grow * MIXD + h * 64;
                      if (!dir) {
#pragma unroll
                          for (int g = 0; g < 4; ++g) { u32x2 o0, o1; o0.x = pk2(y0[4 * g], y0[4 * g + 1]); o0.y = pk2(y0[4 * g + 2], y0[4 * g + 3]); o1.x = pk2(y1[4 * g], y1[4 * g + 1]); o1.y = pk2(y1[4 * g + 2], y1[4 * g + 3]);
                              *(u32x2*)(op + 8 * g + 4 * hh) = o0; *(u32x2*)(op + 32 + 8 * g + 4 * hh) = o1; }
                      } else {
                          f32x16 g0a = ZERO16, g1a = ZERO16; const GM g2g{ws_bf(F, WS_G2T) + (size_t)(h * 64) * 128, 128}; const L128 SG{SL(S_SG)};
                          mm32<8>(g0a, g2g, 0, 0, SG, w * 32, 0, lane); mm32<8>(g1a, g2g, 32, 0, SG, w * 32, 0, lane);
                          float s1 = 0.f;
#pragma unroll
                          for (int g = 0; g < 4; ++g) { const u32x2 f0 = *(const u32x2*)(op + 8 * g + 4 * hh), f1 = *(const u32x2*)(op + 32 + 8 * g + 4 * hh);
                              y0[4 * g] += bflo(f0.x); y0[4 * g + 1] += bfhi(f0.x); y0[4 * g + 2] += bflo(f0.y); y0[4 * g + 3] += bfhi(f0.y);
                              y1[4 * g] += bflo(f1.x); y1[4 * g + 1] += bfhi(f1.x); y1[4 * g + 2] += bflo(f1.y); y1[4 * g + 3] += bfhi(f1.y); }
#pragma unroll
                          for (int r = 0; r < 16; ++r) s1 += y0[r] + y1[r];
                          s1 += __shfl_xor(s1, 32); const float mean = s1 * (1.f / 64.f); float s2 = 0.f;
#pragma unroll
                          for (int r = 0; r < 16; ++r) { const float d0 = y0[r] - mean, d1 = y1[r] - mean; s2 += d0 * d0 + d1 * d1; }
                          s2 += __shfl_xor(s2, 32); const float rstd = rsqrtf(s2 * (1.f / 64.f) + 64e-5f);
                          const float bsv = misc[576 + i];
#pragma unroll
                          for (int g = 0; g < 4; ++g) { float o0[4], o1[4];
                              const f32x4 gw0 = *(const LAS f32x4*)(misc + 640 + 8 * g + 4 * hh), gb0 = *(const LAS f32x4*)(misc + 704 + 8 * g + 4 * hh), gw1 = *(const LAS f32x4*)(misc + 672 + 8 * g + 4 * hh), gb1 = *(const LAS f32x4*)(misc + 736 + 8 * g + 4 * hh);
#pragma unroll
                              for (int e = 0; e < 4; ++e) { const int ch = 8 * g + 4 * hh + e;
                                  const float v0 = bf2f(*(const LAS bf16_t*)(SL(S_VT) + sw64(ch, i))), v1 = bf2f(*(const LAS bf16_t*)(SL(S_VT) + sw64(32 + ch, i)));
                                  o0[e] = ((y0[4 * g + e] - mean) * rstd * gw0[e] + gb0[e] + bsv * v0) * g0a[4 * g + e];
                                  o1[e] = ((y1[4 * g + e] - mean) * rstd * gw1[e] + gb1[e] + bsv * v1) * g1a[4 * g + e]; }
                              u32x2 p0, p1; p0.x = pk2(o0[0], o0[1]); p0.y = pk2(o0[2], o0[3]); p1.x = pk2(o1[0], o1[1]); p1.y = pk2(o1[2], o1[3]);
                              *(u32x2*)(op + 8 * g + 4 * hh) = p0; *(u32x2*)(op + 32 + 8 * g + 4 * hh) = p1; }
                      }
                  } else if (w >= 4) {
                      f32x16 acc = ZERO16;
                      mm32<4>(acc, KH, tj * 32, 0, VT, ti * 32, 0, lane); mm32<4>(acc, BH, tj * 32, 0, U, ti * 32, 0, lane);
                      const int hh = lane >> 5;
#pragma unroll
                      for (int r = 0; r < 16; ++r) sreg[r] = sreg[r] * misc[tj * 32 + crow(r, hh)] + acc[r];
                  } }
                LBAR();
                lane = opaque(lane0);
                if (w >= 4) stT64(sreg, SL(S_SB), ti * 32, tj * 32, lane);
                asm volatile("" :: "v"(pf));
#undef POS
            }
        }
        __syncthreads();
    }
#undef SL
}

__device__ __forceinline__ void ssd_task(const Frame& F, const Args& a, int task, Drip& drip) {
    const int b = task >> 3, grp = (task >> 2) & 1, qd = task & 3, lane0 = F.lane, w = F.wave, hh = w >> 2, sub = w & 3; int lane = lane0, tid = F.tid;
    const int head0 = grp * 8 + qd * 2, head = head0 + hh;
    LAS unsigned char* L = F.lds;
    LAS float* misc = (LAS float*)(F.lds + MISC_OFF);
    LAS unsigned char* BMs = L, *CMs = L + 16384, *BMTs = L + 32768;
    LAS unsigned char* XTs = L + 49152 + hh * 40960, *XDs = XTs + 8192, *Ms = XTs + 16384, *SBFs = XTs + 24576;
    const bf16_t* cols = ws_bf(F, WS_COLS);
    bf16_t* mixin = (bf16_t*)F.dout;
    const float* cw = a.in[I_CONVW]; const float* cb = a.in[I_CONVB];
    const int t0 = F.tid, g48 = t0 % 48, oc = t0 / 48;
    const int ch0 = (g48 < 16) ? (1024 + grp * 128 + g48 * 8) : (g48 < 32 ? (1280 + grp * 128 + (g48 - 16) * 8) : (head0 * 64 + (g48 - 32) * 8));
    const int dth = w - 6;
    for (int dir = 0; dir < 2; ++dir) {
        const float aneg = -__expf(a.in[I_ALOG][dir * 16 + head]), dsk = a.in[I_SSMD][head];
        const float dtb6 = (w >= 6) ? a.in[I_DTB][dir * 16 + head0 + dth] : 0.f, an6 = (w >= 6) ? -__expf(a.in[I_ALOG][dir * 16 + head0 + dth]) : 0.f;
        if (t0 < 384) {
#pragma unroll 1
            for (int tp = 0; tp < 5; ++tp) { *(LAS f32x4*)(misc + 512 + tp * 384 + g48 * 8) = *(const f32x4*)(cw + (dir ? 4 - tp : tp) * 1536 + ch0); *(LAS f32x4*)(misc + 512 + tp * 384 + g48 * 8 + 4) = *(const f32x4*)(cw + (dir ? 4 - tp : tp) * 1536 + ch0 + 4); }
            if (oc == 0) { *(LAS f32x4*)(misc + 2432 + g48 * 8) = *(const f32x4*)(cb + ch0); *(LAS f32x4*)(misc + 2432 + g48 * 8 + 4) = *(const f32x4*)(cb + ch0 + 4); }
        }
        f32x16 st0 = ZERO16, st1 = ZERO16;
        for (int i = tid; i < 4096; i += 512) { ((LAS unsigned*)(L + 49152 + 24576))[i] = 0u; ((LAS unsigned*)(L + 49152 + 40960 + 24576))[i] = 0u; }
        __syncthreads();
        __builtin_amdgcn_sched_barrier(0);
        u32x4 raw[12]; bf16_t dtraw_u = 0; unsigned okm = 0u;
#define CH_LEN(ci) ((ci) < 4 ? CTXL : SEQ)
#define CH_G0(ci) (b * TPB + ((ci) < 4 ? 0 : CTXL))
#define CH_C0(ci) (((ci) < 4 ? (ci) : (ci) - 4) * 64)
#define SSD_PREFETCH(ci) do { const int len_ = CH_LEN(ci), g0_ = CH_G0(ci), c0_ = CH_C0(ci); \
            if (t0 < 384) { const int s0_ = c0_ + 8 * oc - 2; okm = (s0_ < 0 ? 1u : 0u) | (s0_ + 11 >= len_ ? 2u : 0u);        \
                const bf16_t* p_ = cols + (size_t)(g0_ + (dir ? (len_ - 1 - s0_) : s0_)) * EVP + C_XBC + ch0; const long st_ = dir ? -(long)EVP : (long)EVP; \
                _Pragma("unroll") for (int q = 0; q < 12; ++q) raw[q] = *(const u32x4*)(p_ + q * st_); } \
            else if (w >= 6) { const int ps_ = dir ? (len_ - 1 - (c0_ + lane0)) : (c0_ + lane0); dtraw_u = cols[(size_t)(g0_ + ps_) * EVP + C_DT + dir * 16 + head0 + dth]; } } while (0)
        SSD_PREFETCH(0);
        for (int ci = 0; ci < 36; ++ci) {
            const int len = CH_LEN(ci), g0 = CH_G0(ci), c0 = CH_C0(ci);
#define POS(s) (dir ? (len - 1 - (c0 + (s))) : (c0 + (s)))
                lane = opaque(lane0); tid = w * 64 + lane;
                if (t0 < 384) {
                    const int g48o = opaque(g48), oo = opaque(oc);
                    if (okm & 1u) { raw[0] = (u32x4){0u, 0u, 0u, 0u}; raw[1] = raw[0]; }
                    if (okm & 2u) { raw[10] = (u32x4){0u, 0u, 0u, 0u}; raw[11] = raw[10]; }
                    const bool isB = g48o < 16, isC = (g48o >= 16) && (g48o < 32); const int n0 = (g48o & 15) * 8;
                    LAS unsigned char* dstm = isB ? BMs : CMs;
#pragma unroll
                    for (int hf = 0; hf < 2; ++hf) {
                        f32x4 wq[5];
#pragma unroll
                        for (int tp = 0; tp < 5; ++tp) wq[tp] = *(const LAS f32x4*)(misc + 512 + tp * 384 + g48o * 8 + 4 * hf);
                        const f32x4 bq = *(const LAS f32x4*)(misc + 2432 + g48o * 8 + 4 * hf);
                        float ac[8][4];
#pragma unroll
                        for (int j = 0; j < 8; ++j)
#pragma unroll
                            for (int c = 0; c < 4; ++c) ac[j][c] = bq[c];
#pragma unroll
                        for (int q = 0; q < 12; ++q) { const unsigned wd0 = raw[q][2 * hf], wd1 = raw[q][2 * hf + 1]; const float uv[4] = {bflo(wd0), bfhi(wd0), bflo(wd1), bfhi(wd1)};
#pragma unroll
                            for (int j = 0; j < 8; ++j) { if (q - j >= 0 && q - j < 5) {
#pragma unroll
                                    for (int c = 0; c < 4; ++c) ac[j][c] += wq[q - j][c] * uv[c]; } } }
#pragma unroll
                        for (int j = 0; j < 8; ++j)
#pragma unroll
                            for (int c = 0; c < 4; ++c) ac[j][c] = siluf_(ac[j][c]);
                        if (isB || isC) {
#pragma unroll
                            for (int j = 0; j < 8; ++j) { u32x2 pa; pa.x = pk2(ac[j][0], ac[j][1]); pa.y = pk2(ac[j][2], ac[j][3]); *(LAS u32x2*)(dstm + sw128(8 * oo + j, n0 + 4 * hf)) = pa; } }
                        if (isB || !isC) { LAS unsigned char* tb; int trow;
                            if (isB) { tb = BMTs; trow = n0 + 4 * hf; } else { const int pc = (g48o - 32) * 8; tb = L + 49152 + (pc >> 6) * 40960; trow = (pc & 63) + 4 * hf; }
#pragma unroll
                            for (int c = 0; c < 4; ++c) { u32x4 t4; t4.x = pk2(ac[0][c], ac[1][c]); t4.y = pk2(ac[2][c], ac[3][c]); t4.z = pk2(ac[4][c], ac[5][c]); t4.w = pk2(ac[6][c], ac[7][c]); *(LAS u32x4*)(tb + sw64(trow + c, 8 * oo)) = t4; } }
                        __builtin_amdgcn_sched_barrier(0);
                    }
                } else if (w >= 6) {
                    const float dt = softplusf_(bf2f(dtraw_u) + dtb6); float cs = dt * an6;
#pragma unroll
                    for (int o = 1; o < 64; o <<= 1) { const float t = __shfl_up(cs, o); if (lane >= o) cs += t; }
                    misc[dth * 64 + lane] = cs; misc[128 + dth * 64 + lane] = dt; }
                if (ci + 1 < 36) SSD_PREFETCH(ci + 1);
                LBAR();
                lane = opaque(lane0); tid = w * 64 + lane;
#pragma unroll
                for (int it = 0; it < 2; ++it) { const int item = tid + it * 512, hx = item >> 9, p = (item >> 3) & 63, o8i = item & 7;
                    LAS unsigned char* xt = L + 49152 + hx * 40960; float xv[8]; unpack8(*(const LAS u32x4*)(xt + sw64(p, 8 * o8i)), xv);
                    const float ce = misc[hx * 64 + 63]; float f[8];
#pragma unroll
                    for (int j = 0; j < 8; ++j) f[j] = xv[j] * misc[128 + hx * 64 + 8 * o8i + j] * __expf(ce - misc[hx * 64 + 8 * o8i + j]);
                    u32x4 pw; pw.x = pk2(f[0], f[1]); pw.y = pk2(f[2], f[3]); pw.z = pk2(f[4], f[5]); pw.w = pk2(f[6], f[7]); *(LAS u32x4*)(xt + 8192 + sw64(p, 8 * o8i)) = pw; }
                lane = opaque(lane0); tid = w * 64 + lane;
                const int tl = sub & 1, tp2 = sub >> 1;
                drip_issue(F, a, drip, lane);
                unsigned pf = 0u;
                if (dir && ci + 1 < 36 && w < 4) { const int lenn = CH_LEN(ci + 1), pn = lenn - 1 - (CH_C0(ci + 1) + lane); const size_t gr = (size_t)(CH_G0(ci + 1) + pn);
                    const bf16_t* pp = (w < 2) ? mixin + gr * MIXD + 512 + (head0 + w) * 64 : cols + gr * EVP + C_Z + (head0 + w - 2) * 64;
                    pf = *(const unsigned*)pp; }
                f32x16 yacc = ZERO16;
                { const L128 BMm{BMs}, CMm{CMs}, SBm{SBFs};
                  const int l = tl * 32 + (lane & 31), h5 = lane >> 5; const float csl = misc[hh * 64 + l];
                  f32x16 m = ZERO16;
                  if (tp2 <= tl) mm32<8>(m, BMm, tp2 * 32, 0, CMm, tl * 32, 0, lane);
#pragma unroll
                  for (int r = 0; r < 16; ++r) { const int s = tp2 * 32 + crow(r, h5); m[r] = (s <= l) ? m[r] * __expf(csl - misc[hh * 64 + s]) * misc[128 + hh * 64 + s] : 0.f; }
                  stT64(m, Ms, tl * 32, tp2 * 32, lane);
                  mm32<8>(yacc, SBm, tp2 * 32, 0, CMm, tl * 32, 0, lane);
                  const float el = __expf(csl);
#pragma unroll
                  for (int r = 0; r < 16; ++r) yacc[r] *= el; }
                LBAR();
                lane = opaque(lane0); tid = w * 64 + lane;
                { const L64 XTm{XTs}, XDm{XDs}, Mm{Ms}, BMTm{BMTs};
                  mm32<4>(yacc, XTm, tp2 * 32, 0, Mm, tl * 32, 0, lane);
                  const int l = tl * 32 + (lane & 31), h5 = lane >> 5; const size_t grow = (size_t)(g0 + POS(l));
                  bf16_t* op = mixin + grow * MIXD + 512 + head * 64 + tp2 * 32;
                  if (!dir) {
#pragma unroll
                      for (int g = 0; g < 4; ++g) { u32x2 o; o.x = pk2(yacc[4 * g], yacc[4 * g + 1]); o.y = pk2(yacc[4 * g + 2], yacc[4 * g + 3]); *(u32x2*)(op + 8 * g + 4 * h5) = o; }
                  } else {
                      const bf16_t* zp = cols + grow * EVP + C_Z + head * 64 + tp2 * 32;
#pragma unroll
                      for (int g = 0; g < 4; ++g) { const u32x2 f = *(const u32x2*)(op + 8 * g + 4 * h5), zz = *(const u32x2*)(zp + 8 * g + 4 * h5);
                          const float yf[4] = {bflo(f.x), bfhi(f.x), bflo(f.y), bfhi(f.y)}, zv[4] = {bflo(zz.x), bfhi(zz.x), bflo(zz.y), bfhi(zz.y)}; float o4[4];
#pragma unroll
                          for (int e = 0; e < 4; ++e) { const int pch = tp2 * 32 + 8 * g + 4 * h5 + e; const float xv = bf2f(*(const LAS bf16_t*)(XTs + sw64(pch, l)));
                              o4[e] = (yacc[4 * g + e] + yf[e] + dsk * xv) * siluf_(zv[e]); }
                          u32x2 o; o.x = pk2(o4[0], o4[1]); o.y = pk2(o4[2], o4[3]); *(u32x2*)(op + 8 * g + 4 * h5) = o; }
                  }
                  const int tpp = sub & 1, tn0 = (sub >> 1) * 2; const float dE = __expf(misc[hh * 64 + 63]);
                  f32x16 a0 = ZERO16, a1 = ZERO16;
                  mm32<4>(a0, BMTm, tn0 * 32, 0, XDm, tpp * 32, 0, lane); mm32<4>(a1, BMTm, (tn0 + 1) * 32, 0, XDm, tpp * 32, 0, lane);
#pragma unroll
                  for (int r = 0; r < 16; ++r) { st0[r] = st0[r] * dE + a0[r]; st1[r] = st1[r] * dE + a1[r]; } }
                LBAR();
                lane = opaque(lane0);
                { const int tpp = sub & 1, tn0 = (sub >> 1) * 2; stT128(st0, SBFs, tpp * 32, tn0 * 32, lane); stT128(st1, SBFs, tpp * 32, (tn0 + 1) * 32, lane); }
                asm volatile("" :: "v"(pf));
                drip_store(F, a, drip, lane);
#undef POS
        }
        __syncthreads();
#undef SSD_PREFETCH
#undef CH_LEN
#undef CH_G0
#undef CH_C0
    }
}
__device__ __forceinline__ void p_ssm_norm(const Frame& F, const Args& a) {
    bf16_t* mixin = (bf16_t*)F.dout; const float* nw = a.in[I_SSMNW];
    const int gw = F.bid * 8 + F.wave, NGW = F.G * 8;
    for (int g = gw; g < MALL; g += NGW) { bf16_t* rp = mixin + (size_t)g * MIXD + 512 + F.lane * 16;
        float v[16]; { float t0[8], t1[8]; unpack8(*(const u32x4*)rp, t0); unpack8(*(const u32x4*)(rp + 8), t1);
#pragma unroll
            for (int j = 0; j < 8; ++j) { v[j] = t0[j]; v[8 + j] = t1[j]; } }
        float ss = 0.f;
#pragma unroll
        for (int j = 0; j < 16; ++j) ss += v[j] * v[j];
#pragma unroll
        for (int o = 1; o < 32; o <<= 1) ss += __shfl_xor(ss, o);
        const float rs = rsqrtf(ss * (1.f / 512.f) + NORM_EPS);
        u32x4 o0, o1; const float* wv = nw + F.lane * 16;
        o0.x = pk2(v[0] * rs * wv[0], v[1] * rs * wv[1]); o0.y = pk2(v[2] * rs * wv[2], v[3] * rs * wv[3]); o0.z = pk2(v[4] * rs * wv[4], v[5] * rs * wv[5]); o0.w = pk2(v[6] * rs * wv[6], v[7] * rs * wv[7]);
        o1.x = pk2(v[8] * rs * wv[8], v[9] * rs * wv[9]); o1.y = pk2(v[10] * rs * wv[10], v[11] * rs * wv[11]); o1.z = pk2(v[12] * rs * wv[12], v[13] * rs * wv[13]); o1.w = pk2(v[14] * rs * wv[14], v[15] * rs * wv[15]);
        *(u32x4*)rp = o0; *(u32x4*)(rp + 8) = o1; }
}

template <int TW> __device__ __forceinline__ void p_moe_prep_t(const Frame& F, const Args& a, int ly, const float* mods) {
    LAS float* lg = (LAS float*)(F.lds + F.wave * 9728);
    LAS int* mi = (LAS int*)(F.lds + MISC_OFF);
    const bf16_t* xl = ws_bf(F, WS_XL); const bf16_t* xc = ws_bf(F, WS_XC);
    bf16_t* tok = ws_bf(F, WS_TOK);
    unsigned* cnt = (unsigned*)(F.ws + WS_CTL) + CW_CNT + ly * 64 * 32;
    int* list = (int*)(F.ws + WS_LIST); int* tsel = (int*)(F.ws + WS_TSEL); float* tgate = ws_f32(F, WS_TGATE);
    const float* gw = a.in[I_NFFN] + ly * D; const float* rbias = a.in[I_ROUTB] + ly * 64;
    const GM rt{ws_bf(F, WS_ROUT) + (size_t)ly * 64 * 1024, 1024};
    const int lane = F.lane, w = F.wave;
    { int* idl = list + (size_t)(64 + ly) * CAP; const int gt = F.bid * 512 + F.tid, NGT = F.G * 512;
      if (ly == 0) { for (int i = gt; i < MALL; i += NGT) idl[i] = i; } else { for (int i = gt; i < MLAT; i += NGT) idl[i] = (i >> 11) * TPB + CTXL + (i & (SEQ - 1)); } }
    const int ntile = (TW == 36) ? MALL / 288 : (ly ? MLAT / 256 : MALL / 256);
    for (int tq = F.bid; tq < ntile; tq += F.G) { const int tile = ly ? (tq >> 3) * 9 + 1 + (tq & 7) : tq;
        const int gbase = tile * (8 * TW) + w * TW;
        { u32x4 raw[4][2];
          { const bf16_t* src[4];
#pragma unroll
            for (int r = 0; r < 4; ++r) { int mr; src[r] = resid_row_bf(xl, xc, gbase + r, mr); }
            rows4_bf_load(src, raw, lane); }
          for (int r0 = 0; r0 < TW; r0 += 4) { const float* mv[4]; bf16_t* dp[4]; u32x4 nx[4][2];
#pragma unroll
            for (int r = 0; r < 4; ++r) { int mr; const int g = gbase + r0 + r; (void)resid_row_bf(xl, xc, g, mr); mv[r] = mods + (size_t)mr * 6144 + 3 * D; dp[r] = tok + (size_t)g * D; }
            { const bf16_t* src[4]; const int rn = (r0 + 4 < TW) ? r0 + 4 : r0;
#pragma unroll
              for (int r = 0; r < 4; ++r) { int mr; src[r] = resid_row_bf(xl, xc, gbase + rn + r, mr); }
              rows4_bf_load(src, nx, lane); }
            rows4_bf_finish(raw, gw, mv, dp, lane);
#pragma unroll
            for (int r = 0; r < 4; ++r) { raw[r][0] = nx[r][0]; raw[r][1] = nx[r][1]; } } }
        if (F.tid < 64) mi[F.tid] = 0;
        asm volatile("s_waitcnt vmcnt(0)" ::: "memory");
        __syncthreads();
        f32x16 l0 = ZERO16, l1 = ZERO16, l2 = ZERO16, l3 = ZERO16; const GM tk{tok + (size_t)gbase * D, D};
        { const int r_ = lane & 31, h_ = lane >> 5, r2_ = (TW == 36) ? 32 + (r_ & 3) : 0;
#pragma unroll 4
          for (int s = 0; s < 64; ++s) { const bf16x8 bv = tk.get(r_, 2 * s + h_), a0 = rt.get(r_, 2 * s + h_), a1 = rt.get(32 + r_, 2 * s + h_);
              l0 = __builtin_amdgcn_mfma_f32_32x32x16_bf16(a0, bv, l0, 0, 0, 0); l1 = __builtin_amdgcn_mfma_f32_32x32x16_bf16(a1, bv, l1, 0, 0, 0);
              if (TW == 36) { const bf16x8 bw = tk.get(r2_, 2 * s + h_); l2 = __builtin_amdgcn_mfma_f32_32x32x16_bf16(a0, bw, l2, 0, 0, 0); l3 = __builtin_amdgcn_mfma_f32_32x32x16_bf16(a1, bw, l3, 0, 0, 0); } } }
        { const int t = lane & 31, hh = lane >> 5;
#pragma unroll
          for (int r = 0; r < 16; ++r) { lg[t * 66 + crow(r, hh)] = l0[r]; lg[t * 66 + 32 + crow(r, hh)] = l1[r]; }
          if (TW == 36 && t < 4) {
#pragma unroll
              for (int r = 0; r < 16; ++r) { lg[(32 + t) * 66 + crow(r, hh)] = l2[r]; lg[(32 + t) * 66 + 32 + crow(r, hh)] = l3[r]; } } }
        LDS_WAIT();
        int se[6]; float sw_[6]; int lp[6];
        if (lane < TW) { LAS float* row = lg + lane * 66;
            float gs[8];
#pragma unroll
            for (int g = 0; g < 8; ++g) { float m1 = -INFINITY, m2 = -INFINITY;
#pragma unroll
                for (int j = 0; j < 8; ++j) { const int e = 8 * g + j; const float s = sigmoidf_(row[e]) + rbias[e]; row[e] = s; if (s > m1) { m2 = m1; m1 = s; } else if (s > m2) m2 = s; }
                gs[g] = m1 + m2; }
            unsigned gm = 0u;
#pragma unroll
            for (int k = 0; k < 4; ++k) { float best = -INFINITY; int bi = 0;
#pragma unroll
                for (int g = 0; g < 8; ++g) { const bool free_ = !((gm >> g) & 1u); if (free_ && gs[g] > best) { best = gs[g]; bi = g; } }
                gm |= 1u << bi; }
            int gsel = 0, nq = 0;
#pragma unroll
            for (int g = 0; g < 8; ++g) if ((gm >> g) & 1u) {
#pragma unroll
                for (int j = 0; j < 8; ++j) { const float t = row[g * 8 + j]; row[nq * 8 + j] = t; }
                gsel |= g << (3 * nq); ++nq; }
            float cs[32];
#pragma unroll
            for (int c = 0; c < 32; ++c) cs[c] = row[c];
            float wsum = 0.f;
#pragma unroll
            for (int k = 0; k < 6; ++k) { float best = cs[0]; int bi = 0;
#pragma unroll
                for (int c = 1; c < 32; ++c) if (cs[c] > best) { best = cs[c]; bi = c; }
#pragma unroll
                for (int c = 0; c < 32; ++c) cs[c] = (c == bi) ? -INFINITY : cs[c];
                const int be = ((gsel >> (3 * (bi >> 3))) & 7) * 8 + (bi & 7);
                se[k] = be; sw_[k] = best - rbias[be]; wsum += sw_[k]; }
            const float inv = 2.5f / wsum;
#pragma unroll
            for (int k = 0; k < 6; ++k) { sw_[k] *= inv; lp[k] = __hip_atomic_fetch_add(&mi[se[k]], 1, __ATOMIC_RELAXED, __HIP_MEMORY_SCOPE_WORKGROUP); }
        }
        __syncthreads();
        if (F.tid < 64) { const int c = mi[F.tid]; mi[64 + F.tid] = c ? (int)atomicAdd(&cnt[F.tid * 32], (unsigned)c) : 0; }
        __syncthreads();
        if (lane < TW) { const int g = gbase + lane;
#pragma unroll
            for (int k = 0; k < 6; ++k) { const int pos = mi[64 + se[k]] + lp[k]; list[(size_t)se[k] * CAP + pos] = g; tsel[(size_t)g * 8 + k] = (se[k] << 20) | pos; tgate[(size_t)g * 8 + k] = sw_[k]; } }
        __syncthreads();
    }
}
__device__ __forceinline__ void p_moe_prep(const Frame& F, const Args& a, int ly, const float* mods) {
    if (ly == 0 && F.G == 256) p_moe_prep_t<36>(F, a, ly, mods); else p_moe_prep_t<32>(F, a, ly, mods);
}
__device__ __forceinline__ void moe_tables(const Frame& F, int ly) {
    LAS int* mi = (LAS int*)(F.lds + MISC_OFF);
    __syncthreads();
    if (F.tid < 65) { const unsigned* cnt = (const unsigned*)(F.ws + WS_CTL) + CW_CNT + ly * 64 * 32;
        mi[512 + F.tid] = (F.tid < 64) ? (int)__hip_atomic_load(cnt + F.tid * 32, __ATOMIC_RELAXED, __HIP_MEMORY_SCOPE_AGENT) : (ly ? MLAT : MALL); }
    __syncthreads();
    if (F.tid == 0) { int ts = 0, rs = 0;
        for (int e = 0; e < 65; ++e) { const int n = mi[512 + e]; mi[256 + e] = ts; mi[384 + e] = rs; ts += (n + 255) >> 8; rs += n; }
        mi[256 + 65] = ts; mi[384 + 65] = rs; }
    __syncthreads();
}
struct MoeSched {
    LAS int* mi; int nN, G, c, ly, mode  , half;
    __device__ __forceinline__ bool next(int i, pg8::Unit& u) const {
        const int cx = (G == 256) ? ((c & 7) * 32 + (c >> 3)) : c;
        const int Ttot = mi[256 + 65], nfull = (Ttot / G) * nN, lane = threadIdx.x & 63;
        int T, pn;
        if (i < nfull) { T = (i / nN) * G + cx; pn = i % nN; }
        else { const int j = (i - nfull) * G + cx; if (j >= (Ttot % G) * nN) return false; T = (Ttot / G) * G + j / nN; pn = j % nN; }
        const int e = __builtin_amdgcn_readfirstlane(__popcll(__ballot(mi[256 + 1 + lane] <= T)));
        const int lt = T - mi[256 + e], n = mi[512 + e], r0 = mi[384 + e] + lt * 256;
        u.e = e; u.nv = (n - lt * 256) < 256 ? (n - lt * 256) : 256; u.cr = r0; u.cc = pn * 256;
        if (mode == 1) { u.ar = (e < 64 ? e : 64 + ly) * CAP + lt * 256; u.br = (ly * 65 + e) * 512 + pn * 256; }
        else { u.ar = r0; u.br = (ly * 65 + e) * 1024 + pn * 256; }
        return true;
    }
};
template <int FUSE> __device__ __forceinline__ void p_moe_combine(const Frame& F, int ly, const float* mods, float rscale, const float* gnext, const float* modsn, bf16_t* nxt, float* outp) {
    LAS int* mi = (LAS int*)(F.lds + MISC_OFF);
    bf16_t* xl = ws_bf(F, WS_XL); bf16_t* xc = ws_bf(F, WS_XC);
    const unsigned char* ya = (const unsigned char*)F.dout; const unsigned char* yb = F.ws + WS_YB;
    const int* tsel = (const int*)(F.ws + WS_TSEL); const float* tgate = ws_f32(F, WS_TGATE);
    const int gw = F.bid * 8 + F.wave, NGW = F.G * 8, lane = F.lane;
    const int NT = ly ? MLAT : MALL, shrow = mi[384 + 64];
    for (int i0 = gw; i0 < NT; i0 += 2 * NGW) {
        u32x4 yv[2][7], dv[2][2]; float wk[2][7]; f32x4 gg[2][4]; bf16_t* dstq[2]; int gq[2], mrq[2], lrq[2];
#pragma unroll
        for (int q = 0; q < 2; ++q) { const int ix = (i0 + q * NGW < NT) ? i0 + q * NGW : i0;
            int g, b, p; if (ly) { b = ix >> 11; p = CTXL + (ix & (SEQ - 1)); g = b * TPB + p; } else { g = ix; b = g / TPB; p = g - b * TPB; }
            gq[q] = g; mrq[q] = p < CTXL ? 32 : b; lrq[q] = b * SEQ + p - CTXL;
            dstq[q] = (p < CTXL ? xc + (size_t)(b * CTXL + p) * D : xl + (size_t)lrq[q] * D) + lane * 16;
#pragma unroll
            for (int k = 0; k < 7; ++k) { int row; if (k < 6) { const int ts = tsel[(size_t)g * 8 + k]; wk[q][k] = tgate[(size_t)g * 8 + k] * Y8_INV * rscale; row = mi[384 + (ts >> 20)] + (ts & 0xFFFFF); }
                else { wk[q][k] = Y8_INV * rscale; row = shrow + ix; }
                yv[q][k] = *(const u32x4*)((row < YSPLIT ? ya + (size_t)row * 1024 : yb + (size_t)(row - YSPLIT) * 1024) + lane * 16); }
            dv[q][0] = *(const u32x4*)dstq[q]; dv[q][1] = *(const u32x4*)(dstq[q] + 8);
            const float* gv = mods + (size_t)mrq[q] * 6144 + 5 * D + lane * 16;
#pragma unroll
            for (int c = 0; c < 4; ++c) gg[q][c] = *(const f32x4*)(gv + 4 * c); }
#pragma unroll
        for (int q = 0; q < 2; ++q) { if (q && i0 + NGW >= NT) continue;
            bf16_t* dst = dstq[q]; const int g = gq[q], mr = mrq[q];
            f32x4 o[4];
            { const u32x4 d0 = dv[q][0], d1 = dv[q][1];
              o[0] = (f32x4){bflo(d0.x), bfhi(d0.x), bflo(d0.y), bfhi(d0.y)}; o[1] = (f32x4){bflo(d0.z), bfhi(d0.z), bflo(d0.w), bfhi(d0.w)};
              o[2] = (f32x4){bflo(d1.x), bfhi(d1.x), bflo(d1.y), bfhi(d1.y)}; o[3] = (f32x4){bflo(d1.z), bfhi(d1.z), bflo(d1.w), bfhi(d1.w)}; }
            float acc[16];
#pragma unroll
            for (int j = 0; j < 16; ++j) acc[j] = 0.f;
#pragma unroll
            for (int k = 0; k < 7; ++k)
#pragma unroll
                for (int c = 0; c < 4; ++c) { const f32x2 lo = __builtin_amdgcn_cvt_pk_f32_fp8((int)yv[q][k][c], false), hi = __builtin_amdgcn_cvt_pk_f32_fp8((int)yv[q][k][c], true);
                    acc[4 * c] += wk[q][k] * lo[0]; acc[4 * c + 1] += wk[q][k] * lo[1]; acc[4 * c + 2] += wk[q][k] * hi[0]; acc[4 * c + 3] += wk[q][k] * hi[1]; }
            float ss = 0.f;
#pragma unroll
            for (int c = 0; c < 4; ++c) { o[c] += gg[q][c] * (f32x4){acc[4 * c], acc[4 * c + 1], acc[4 * c + 2], acc[4 * c + 3]};
                ss += o[c][0] * o[c][0] + o[c][1] * o[c][1] + o[c][2] * o[c][2] + o[c][3] * o[c][3]; }
            if (FUSE != 2) { u32x4 w0, w1; w0.x = pk2(o[0][0], o[0][1]); w0.y = pk2(o[0][2], o[0][3]); w0.z = pk2(o[1][0], o[1][1]); w0.w = pk2(o[1][2], o[1][3]);
                w1.x = pk2(o[2][0], o[2][1]); w1.y = pk2(o[2][2], o[2][3]); w1.z = pk2(o[3][0], o[3][1]); w1.w = pk2(o[3][2], o[3][3]); *(u32x4*)dst = w0; *(u32x4*)(dst + 8) = w1; }
            if (FUSE) { const float rs = rsqrtf(wave_sum(ss) * (1.f / D) + NORM_EPS);
                if (FUSE == 1) { const float* mv = modsn + (size_t)mr * 6144 + lane * 16; bf16_t* np = nxt + (size_t)g * D + lane * 16;
#pragma unroll
                    for (int c = 0; c < 4; ++c) { const f32x4 g4 = *(const f32x4*)(gnext + lane * 16 + 4 * c), sh = *(const f32x4*)(mv + 4 * c), sc = *(const f32x4*)(mv + D + 4 * c);
                        const f32x4 v = (o[c] * rs * g4) * (1.f + sc) + sh; u32x2 wv; wv.x = pk2(v[0], v[1]); wv.y = pk2(v[2], v[3]); *(u32x2*)(np + 4 * c) = wv; } }
                else { float* op = outp + (size_t)lrq[q] * D + lane * 16;
#pragma unroll
                    for (int c = 0; c < 4; ++c) { const f32x4 g4 = *(const f32x4*)(gnext + lane * 16 + 4 * c); *(f32x4*)(op + 4 * c) = o[c] * rs * g4; } } } } }
}

__device__ __forceinline__ void p_mla_prep(const Frame& F, const Args& a) {
    const bf16_t* cmp = (const bf16_t*)F.dout; bf16_t* cqn = ws_bf(F, WS_CQN); bf16_t* ckvn = ws_bf(F, WS_CKVN); bf16_t* kr = ws_bf(F, WS_KR); const float* rope = ws_f32(F, WS_ROPE);
    const float* qn = a.in[I_MLAQN]; const float* kvn = a.in[I_MLAKVN];
    const int gw = F.bid * 8 + F.wave, NGW = F.G * 8, lane = F.lane;
    const f32x4 gkv = *(const f32x4*)(kvn + lane * 4); float gq[6];
#pragma unroll
    for (int j = 0; j < 6; ++j) gq[j] = qn[lane * 6 + j];
    for (int g0 = gw; g0 < MALL; g0 += 4 * NGW) {
        int gi[4]; u32x2 rkv[4]; unsigned rq[4][3]; bf16_t rr[4];
#pragma unroll
        for (int q = 0; q < 4; ++q) { gi[q] = (g0 + q * NGW < MALL) ? g0 + q * NGW : g0; const bf16_t* row = cmp + (size_t)gi[q] * MLAP;
            rkv[q] = *(const u32x2*)(row + 384 + lane * 4); const unsigned* rw = (const unsigned*)(row + lane * 6); rq[q][0] = rw[0]; rq[q][1] = rw[1]; rq[q][2] = rw[2]; rr[q] = row[640 + (lane & 31)]; }
#pragma unroll
        for (int q = 0; q < 4; ++q) { const int g = gi[q], b = g / TPB, p = g - b * TPB; if (q > 0 && g0 + q * NGW >= MALL) continue;
            { const float v[4] = {bflo(rkv[q].x), bfhi(rkv[q].x), bflo(rkv[q].y), bfhi(rkv[q].y)};
              const float ss = wave_sum(v[0] * v[0] + v[1] * v[1] + v[2] * v[2] + v[3] * v[3]); const float rs = rsqrtf(ss * (1.f / 256.f) + NORM_EPS);
              u32x2 o; o.x = pk2(v[0] * rs * gkv[0], v[1] * rs * gkv[1]); o.y = pk2(v[2] * rs * gkv[2], v[3] * rs * gkv[3]); *(u32x2*)(ckvn + (size_t)g * 256 + lane * 4) = o; }
            { float x = (lane < 32) ? bf2f(rr[q]) : 0.f;
              if (p >= CTXL) { const int t = p - CTXL; const float other = __shfl_xor(x, 16); const int i = lane & 15; const float cs = rope[t * 16 + i], sn = rope[SEQ * 16 + t * 16 + i];
                  x = (lane & 16) ? (other * sn + x * cs) : (x * cs - other * sn); }
              if (lane < 32) kr[(size_t)g * 32 + lane] = f2bf(x); }
            if (p >= CTXL) { const size_t lr = (size_t)(b * SEQ + p - CTXL);
                const float v[6] = {bflo(rq[q][0]), bfhi(rq[q][0]), bflo(rq[q][1]), bfhi(rq[q][1]), bflo(rq[q][2]), bfhi(rq[q][2])};
                const float ss = wave_sum(v[0] * v[0] + v[1] * v[1] + v[2] * v[2] + v[3] * v[3] + v[4] * v[4] + v[5] * v[5]); const float rs = rsqrtf(ss * (1.f / 384.f) + NORM_EPS);
                unsigned* o = (unsigned*)(cqn + lr * 384 + lane * 6);
                o[0] = pk2(v[0] * rs * gq[0], v[1] * rs * gq[1]); o[1] = pk2(v[2] * rs * gq[2], v[3] * rs * gq[3]); o[2] = pk2(v[4] * rs * gq[4], v[5] * rs * gq[5]); } } }
}
constexpr int AT_KO = 0, AT_RO = 8192, AT_VO = 12288, AT_STAGE = 20480;
__device__ __forceinline__ void p_attention(const Frame& F) {
    const bf16_t* Q = ws_bf(F, WS_Q); const bf16_t* KN = ws_bf(F, WS_KN); const bf16_t* KR = ws_bf(F, WS_KR); const bf16_t* VT = (const bf16_t*)F.dout; bf16_t* O = ws_bf(F, WS_O);
    const int tid = F.tid, lane = F.lane, w = F.wave, r32 = lane & 31, hh = lane >> 5;
    LAS unsigned char* L = F.lds;
    const int nIt = (F.G == 256) ? (NB * 16 * 4) / 256 : (NB * 16 * 4 + F.G - 1) / F.G;
    for (int it = 0; it < nIt; ++it) {
        int bh, qb;
        if (F.G == 256) { const int xcd = F.bid & 7, slot = F.bid >> 3; bh = (it * 8 + (slot >> 2)) * 8 + xcd; qb = slot & 3; }
        else { const int U = it * F.G + F.bid; if (U >= NB * 16 * 4) break; bh = U >> 2; qb = U & 3; }
        const int b = bh >> 4, h = bh & 15;
        const size_t qrow = (size_t)b * SEQ + qb * 512 + w * 64 + r32;
        bf16x8 qf[2][6];
#pragma unroll
        for (int qi = 0; qi < 2; ++qi)
#pragma unroll
            for (int s = 0; s < 6; ++s) qf[qi][s] = *(const bf16x8*)(Q + (qrow + 32 * qi) * 1536 + h * 96 + 16 * s + 8 * hh);
        const size_t kv0g = (size_t)b * TPB;
        const bf16_t* kp = KN + (kv0g + lane) * 1024 + h * 64 + w * 8;
        const bf16_t* rp = KR + (kv0g + lane) * 32 + (w & 3) * 8;
        const bf16_t* vp = VT + (size_t)(h * 64 + lane) * MALL + kv0g + w * 8;
        const int kb = hh * 1024 + r32 * 16, vb = AT_VO + r32 * 16 + 8 * hh;
#define AT_DMA(t, stg) do { __builtin_amdgcn_global_load_lds((const unsigned*)(kp + (size_t)(t) * 64 * 1024), (LAS unsigned*)((stg) + AT_KO + w * 1024), 16, 0, 0); \
            if (w < 4) __builtin_amdgcn_global_load_lds((const unsigned*)(rp + (size_t)(t) * 64 * 32), (LAS unsigned*)((stg) + AT_RO + w * 1024), 16, 0, 0); \
            __builtin_amdgcn_global_load_lds((const unsigned*)(vp + (t) * 64), (LAS unsigned*)((stg) + AT_VO + w * 1024), 16, 0, 0); } while (0)
        AT_DMA(0, L);
        __syncthreads();
        f32x16 o[2][2]; float mrun[2] = {0.f, 0.f}, lsum[2] = {0.f, 0.f};
#pragma unroll
        for (int qi = 0; qi < 2; ++qi) { o[qi][0] = ZERO16; o[qi][1] = ZERO16; }
        constexpr int NT = TPB / 64;
        for (int t = 0; t < NT; ++t) {
            LAS unsigned char* cur = L + (t & 1) * AT_STAGE; LAS unsigned char* nxt = L + ((t + 1) & 1) * AT_STAGE;
            if (t + 1 < NT) AT_DMA(t + 1, nxt);
            f32x16 p[2][2];
#pragma unroll
            for (int qi = 0; qi < 2; ++qi) { const float nm = -mrun[qi];
#pragma unroll
                for (int r = 0; r < 16; ++r) { p[qi][0][r] = nm; p[qi][1][r] = nm; } }
#pragma unroll
            for (int s = 0; s < 6; ++s) { const bf16x8 k0 = *(const LAS bf16x8*)(cur + kb + s * 2048), k1 = *(const LAS bf16x8*)(cur + kb + s * 2048 + 512);
#pragma unroll
                for (int qi = 0; qi < 2; ++qi) { p[qi][0] = __builtin_amdgcn_mfma_f32_32x32x16_bf16(k0, qf[qi][s], p[qi][0], 0, 0, 0); p[qi][1] = __builtin_amdgcn_mfma_f32_32x32x16_bf16(k1, qf[qi][s], p[qi][1], 0, 0, 0); } }
            float mx[2];
#pragma unroll
            for (int qi = 0; qi < 2; ++qi) { const f32x16& p0 = p[qi][0]; const f32x16& p1 = p[qi][1];
                float ma = fmaxf(fmaxf(p0[0], p0[1]), p1[0]), mb = fmaxf(fmaxf(p0[2], p0[3]), p1[1]); ma = fmaxf(fmaxf(ma, p1[2]), p1[3]);
#pragma unroll
                for (int r = 4; r < 16; r += 4) { ma = fmaxf(fmaxf(ma, p0[r]), p0[r + 1]); mb = fmaxf(fmaxf(mb, p0[r + 2]), p0[r + 3]); ma = fmaxf(fmaxf(ma, p1[r]), p1[r + 1]); mb = fmaxf(fmaxf(mb, p1[r + 2]), p1[r + 3]); }
                float m_ = fmaxf(ma, mb);
                auto rr = __builtin_amdgcn_permlane32_swap(__float_as_uint(m_), __float_as_uint(m_), false, false); mx[qi] = fmaxf(__uint_as_float(rr[0]), __uint_as_float(rr[1])); }
            if (t == 0 || __any(fmaxf(mx[0], mx[1]) > 8.f)) {
#pragma unroll
                for (int qi = 0; qi < 2; ++qi) { const float dl = (t == 0) ? mx[qi] : fmaxf(mx[qi], 0.f); mrun[qi] += dl; const float alpha = __builtin_amdgcn_exp2f(-dl); lsum[qi] *= alpha;
#pragma unroll
                    for (int r = 0; r < 16; ++r) { p[qi][0][r] -= dl; p[qi][1][r] -= dl; o[qi][0][r] *= alpha; o[qi][1][r] *= alpha; } } }
#pragma unroll
            for (int qi = 0; qi < 2; ++qi) { float ps = 0.f;
#pragma unroll
                for (int r = 0; r < 16; ++r) { p[qi][0][r] = __builtin_amdgcn_exp2f(p[qi][0][r]); p[qi][1][r] = __builtin_amdgcn_exp2f(p[qi][1][r]); ps += p[qi][0][r] + p[qi][1][r]; }
                lsum[qi] += ps; }
#pragma unroll
            for (int kvh = 0; kvh < 2; ++kvh)
#pragma unroll
                for (int s2 = 0; s2 < 2; ++s2) { const int c = kvh * 4 + 2 * s2;
                    const u32x2 a00 = *(const LAS u32x2*)(cur + vb + c * 1024), a01 = *(const LAS u32x2*)(cur + vb + c * 1024 + 1024);
                    const u32x2 a10 = *(const LAS u32x2*)(cur + vb + c * 1024 + 512), a11 = *(const LAS u32x2*)(cur + vb + c * 1024 + 1536);
                    const bf16x8 va0 = __builtin_bit_cast(bf16x8, (u32x4){a00.x, a00.y, a01.x, a01.y}), va1 = __builtin_bit_cast(bf16x8, (u32x4){a10.x, a10.y, a11.x, a11.y});
#pragma unroll
                    for (int qi = 0; qi < 2; ++qi) { const f32x16& pp = p[qi][kvh]; u32x4 pw; pw.x = pk2(pp[8 * s2], pp[8 * s2 + 1]); pw.y = pk2(pp[8 * s2 + 2], pp[8 * s2 + 3]); pw.z = pk2(pp[8 * s2 + 4], pp[8 * s2 + 5]); pw.w = pk2(pp[8 * s2 + 6], pp[8 * s2 + 7]);
                        const bf16x8 pb = __builtin_bit_cast(bf16x8, pw);
                        o[qi][0] = __builtin_amdgcn_mfma_f32_32x32x16_bf16(va0, pb, o[qi][0], 0, 0, 0); o[qi][1] = __builtin_amdgcn_mfma_f32_32x32x16_bf16(va1, pb, o[qi][1], 0, 0, 0); } }
            __syncthreads();
        }
#undef AT_DMA
#pragma unroll
        for (int qi = 0; qi < 2; ++qi) { float ls = lsum[qi]; ls += __shfl_xor(ls, 32); const float il = __builtin_amdgcn_rcpf(ls);
            bf16_t* op = O + (qrow + 32 * qi) * D + h * 64;
#pragma unroll
            for (int g = 0; g < 4; ++g) { const f32x16& o0 = o[qi][0]; const f32x16& o1 = o[qi][1];
                u32x2 a0, a1; a0.x = pk2(o0[4 * g] * il, o0[4 * g + 1] * il); a0.y = pk2(o0[4 * g + 2] * il, o0[4 * g + 3] * il); a1.x = pk2(o1[4 * g] * il, o1[4 * g + 1] * il); a1.y = pk2(o1[4 * g + 2] * il, o1[4 * g + 3] * il);
                *(u32x2*)(op + 8 * g + 4 * hh) = a0; *(u32x2*)(op + 32 + 8 * g + 4 * hh) = a1; } }
    }
}
__device__ __forceinline__ void p_final(const Frame& F, const Args& a) {
    const bf16_t* xl = ws_bf(F, WS_XL); const float* gw = a.in[I_FNORM]; float* out = (float*)F.dout;
    const int gwv = F.bid * 8 + F.wave, NGW = F.G * 8, lane = F.lane;
    for (int r0 = gwv; r0 < MLAT; r0 += 4 * NGW) { u32x4 raw[4][2]; float ss[4];
#pragma unroll
        for (int q = 0; q < 4; ++q)
#pragma unroll
            for (int j = 0; j < 2; ++j) raw[q][j] = *(const u32x4*)(xl + (size_t)(r0 + q * NGW < MLAT ? r0 + q * NGW : r0) * D + 8 * lane + 512 * j);
#pragma unroll
        for (int q = 0; q < 4; ++q) { float s = 0.f;
#pragma unroll
            for (int j = 0; j < 2; ++j) { float v[8]; unpack8(raw[q][j], v);
#pragma unroll
                for (int c = 0; c < 8; ++c) s += v[c] * v[c]; }
            ss[q] = rsqrtf(wave_sum(s) * (1.f / D) + NORM_EPS); }
#pragma unroll
        for (int j = 0; j < 2; ++j) { const int c0 = 8 * lane + 512 * j; const f32x4 g0 = *(const f32x4*)(gw + c0), g1 = *(const f32x4*)(gw + c0 + 4);
#pragma unroll
            for (int q = 0; q < 4; ++q) { if (r0 + q * NGW >= MLAT) continue; float v[8]; unpack8(raw[q][j], v); float* op = out + (size_t)(r0 + q * NGW) * D + c0;
                *(f32x4*)op = (f32x4){v[0], v[1], v[2], v[3]} * ss[q] * g0; *(f32x4*)(op + 4) = (f32x4){v[4], v[5], v[6], v[7]} * ss[q] * g1; } } }
}

constexpr int N_PHASES = 20;
__global__ void __launch_bounds__(512, 2) fwd_kernel(Args args) {
    extern __shared__ __attribute__((aligned(16))) unsigned char lds_raw[];
    Frame F;
    F.lds = (LAS unsigned char*)lds_raw;
    F.tid = threadIdx.x; F.lane = F.tid & 63; F.wave = __builtin_amdgcn_readfirstlane(F.tid >> 6);
    F.G = gridDim.x; F.bid = blockIdx.x; F.ws = args.ws; F.dout = (unsigned char*)args.out;
    volatile LAS unsigned* BW = (volatile LAS unsigned*)(F.lds + MISC_OFF + 12288);
    if (F.tid == 0) { BW[0] = 0u; BW[1] = 0u; BW[2] = 0u; BW[3] = 0u; }
    __syncthreads();
    XcdBarrier bar; bar.bar = (unsigned*)(F.ws + WS_CTL) + CW_BAR; bar.x = 0; bar.st = nullptr;
    if (!MK_PER_PHASE) bar = xcd_barrier_post((unsigned*)(F.ws + WS_CTL) + CW_BAR, BW);
    const int lo = args.ph_lo, hi = args.ph_hi;
#ifndef PHMASK
#define PHMASK 0xFFFFFFFFu
#endif
#define IN(k) (((PHMASK >> (k)) & 1u) && lo <= (k) && (k) < hi)
#ifndef REP_PHASE
#define REP_PHASE -1
#endif
#define NREP(k) (((k) == REP_PHASE) ? 2 : 1)
#define REPL(k) for (int rep_ = 0; rep_ < NREP(k); ++rep_)
#define REPB() do { if (rep_) { if (!MK_PER_PHASE) xcd_barrier(bar); } } while (0)
#define SEAM(k) do { if (IN(k) && IN((k) + 1)) { if (!MK_PER_PHASE) xcd_barrier(bar); } } while (0)
#define XTASK(t) ((F.G == 256) ? (((((t) >> 3) >> 3) * 8 + ((t) & 7)) * 8 + (((t) >> 3) & 7)) : (t))
    const float* mods0 = ws_f32(F, WS_MODS); const float* mods1 = mods0 + 33 * 6144;
    LAS int* mi = (LAS int*)(F.lds + MISC_OFF);

    if (IN(0)) REPL(0) { REPB(); p0_mods(F, args); p0_convert(F, args); } SEAM(0);
    if (IN(1)) REPL(1) { REPB(); p_normmod(F, args.in[I_X], args.in[I_CTX], args.in[I_NMIX], mods0, 0, (bf16_t*)F.dout); } SEAM(1);
    if (IN(2)) REPL(2) { REPB(); pg8::Gemm g{(const bf16_t*)F.dout, ws_bf(F, WS_WIN), D, D, D, nullptr}; pg8::DenseSched S; S.init(MALL, EVP, F.G, F.bid); EpiBf16 E{ws_bf(F, WS_COLS), EVP};
        pg8::gemm_phase<EpiBf16, pg8::DenseSched, false>(F.lds + RING_OFF, g, S, E); } SEAM(2);
    if (IN(3)) REPL(3) { REPB(); Drip drip; drip.c = 0;
#pragma unroll
        for (int j = 0; j < 8; ++j) { drip.v[j] = 0.f; drip.v2[j] = 0.f; }
        for (int r2 = 0; r2 < (REP_PHASE == 103 ? 2 : 1); ++r2) for (int t = F.bid; t < 256; t += F.G) rwkv_task(F, args, XTASK(t)); for (int r2 = 0; r2 < (REP_PHASE == 104 ? 2 : 1); ++r2) for (int t = F.bid; t < 256; t += F.G) ssd_task(F, args, XTASK(t), drip);
        while (2 * drip.c * F.G * 8 < DRIP_UNITS) { drip_issue(F, args, drip, F.lane); drip_store(F, args, drip, F.lane); } } SEAM(3);
    if (IN(4)) REPL(4) { REPB(); p_ssm_norm(F, args); } SEAM(4);
    if (IN(5)) REPL(5) { REPB(); pg8::Gemm g{(const bf16_t*)F.dout, ws_bf(F, WS_WOUT), MIXD, MIXD, MIXD, nullptr}; pg8::DenseSched S; S.init(MALL, D, F.G, F.bid);
        EpiResid<0> E{args.in[I_X], args.in[I_CTX], ws_bf(F, WS_XL), ws_bf(F, WS_XC), mods0};
        pg8::gemm_phase<EpiResid<0>, pg8::DenseSched, false>(F.lds + RING_OFF, g, S, E); } SEAM(5);
#define MOE_PHASES(P, ly, modsL) \
    if (IN(P)) { p_moe_prep(F, args, ly, modsL); } SEAM(P); \
    if (IN((P) + 1)) REPL((P) + 1) { REPB(); moe_tables(F, ly); pg8::Gemm g{ws_bf(F, WS_TOK), ws_bf(F, WS_W13), D, D, D, (const int*)(F.ws + WS_LIST)}; MoeSched S{mi, 2, F.G, F.bid, ly, 1, 0}; EpiGlu E{ws_bf(F, WS_HID)}; \
        pg8::gemm_phase<EpiGlu, MoeSched, true>(F.lds + RING_OFF, g, S, E); } SEAM((P) + 1); \
    if (IN((P) + 2)) REPL((P) + 2) { REPB(); moe_tables(F, ly); pg8::Gemm g{ws_bf(F, WS_HID), ws_bf(F, WS_W2E), EFF, EFF, EFF, nullptr}; MoeSched S{mi, 4, F.G, F.bid, ly, 2, 0}; \
        EpiMoeDown E{F.dout, F.ws + WS_YB}; \
        pg8::gemm_phase<EpiMoeDown, MoeSched, false>(F.lds + RING_OFF, g, S, E); } SEAM((P) + 2); \
    if (IN((P) + 3)) { moe_tables(F, ly); COMBINE_CALL; } SEAM((P) + 3);
#define COMBINE_CALL p_moe_combine<1>(F, 0, mods0, 1.f, args.in[I_NMIX] + D, mods1, ws_bf(F, WS_HA1), nullptr)
    MOE_PHASES(6, 0, mods0)
#undef COMBINE_CALL
    if (IN(10)) REPL(10) { REPB(); pg8::Gemm g{ws_bf(F, WS_HA1), ws_bf(F, WS_WMLA), D, D, D, nullptr}; pg8::DenseSched S; S.init(MALL, MLAP, F.G, F.bid); EpiBf16 E{(bf16_t*)F.dout, MLAP};
        pg8::gemm_phase<EpiBf16, pg8::DenseSched, false>(F.lds + RING_OFF, g, S, E); } SEAM(10);
    if (IN(11)) REPL(11) { REPB(); p_mla_prep(F, args); } SEAM(11);
    if (IN(12)) REPL(12) { REPB();
        { pg8::Gemm g{ws_bf(F, WS_CQN), ws_bf(F, WS_WQ), 384, 384, 384, nullptr}; pg8::DenseSched S; S.init(MLAT, 1536, F.G, F.bid); EpiQ E{ws_bf(F, WS_Q), ws_f32(F, WS_ROPE)};
          pg8::gemm_phase<EpiQ, pg8::DenseSched, false>(F.lds + RING_OFF, g, S, E); }
        { pg8::Gemm g{ws_bf(F, WS_CKVN), ws_bf(F, WS_WK), 256, 256, 256, nullptr}; pg8::DenseSched S; S.init(MALL, 1024, F.G, F.bid); EpiBf16 E{ws_bf(F, WS_KN), D};
          pg8::gemm_phase<EpiBf16, pg8::DenseSched, false>(F.lds + RING_OFF, g, S, E); }
        { pg8::Gemm g{ws_bf(F, WS_WV), ws_bf(F, WS_CKVN), 256, 256, 256, nullptr}; pg8::DenseSched S; S.init(1024, MALL, F.G, F.G - 1 - F.bid); EpiBf16 E{(bf16_t*)F.dout, MALL};
          pg8::gemm_phase<EpiBf16, pg8::DenseSched, false>(F.lds + RING_OFF, g, S, E); }
    } SEAM(12);
    if (IN(13)) REPL(13) { REPB(); p_attention(F); } SEAM(13);
    if (IN(14)) { pg8::Gemm g{ws_bf(F, WS_O), ws_bf(F, WS_WO), D, D, D, nullptr}; pg8::DenseSched S; S.init(MLAT, D, F.G, F.bid);
        EpiResid<1> E{nullptr, nullptr, ws_bf(F, WS_XL), nullptr, mods1};
        pg8::gemm_phase<EpiResid<1>, pg8::DenseSched, false>(F.lds + RING_OFF, g, S, E); } SEAM(14);
#define COMBINE_CALL p_moe_combine<0>(F, 1, mods1, 1.f, nullptr, nullptr, nullptr, nullptr)
    MOE_PHASES(15, 1, mods1)
#undef COMBINE_CALL
    if (IN(19)) { p_final(F, args); }
#undef IN
#undef SEAM
}

extern "C" void kernel_launch(void* const* d_in, const int* in_sizes, int n_in, void* d_out, int out_size, void* d_ws, size_t ws_size, hipStream_t stream) {
    static int grid = 0;
    if (grid == 0) {
        if (n_in != 42 || out_size != MLAT * D || ws_size < WS_END) { fprintf(stderr, "kernel_launch: unexpected shapes: n_in %d out %d ws %zu (need %zu)\n", n_in, out_size, ws_size, (size_t)WS_END); grid = -1; return; }
        int dev = 0, cus = 0, per_cu = 0;
        if (hipGetDevice(&dev) != hipSuccess || hipDeviceGetAttribute(&cus, hipDeviceAttributeMultiprocessorCount, dev) != hipSuccess) { grid = -1; return; }
        if (hipFuncSetAttribute((const void*)fwd_kernel, hipFuncAttributeMaxDynamicSharedMemorySize, LDS_BYTES) != hipSuccess) { fprintf(stderr, "kernel_launch: hipFuncSetAttribute failed\n"); grid = -1; return; }
        if (hipOccupancyMaxActiveBlocksPerMultiprocessor(&per_cu, (const void*)fwd_kernel, 512, LDS_BYTES) != hipSuccess || per_cu < 1) fprintf(stderr, "kernel_launch: occupancy query says %d\n", per_cu);
        (void)hipGetLastError();
        grid = cus;
    }
    if (grid < 0) return;
    (void)hipMemsetAsync((char*)d_ws + WS_CTL, 0, CTL_BYTES, stream);
    Args a{};
    for (int i = 0; i < 42; ++i) a.in[i] = (const float*)d_in[i];
    a.out = (float*)d_out; a.ws = (unsigned char*)d_ws;
#if MK_PER_PHASE
    for (int p = 0; p < N_PHASES; ++p) { a.ph_lo = p; a.ph_hi = p + 1; hipLaunchKernelGGL(fwd_kernel, dim3(grid), dim3(512), LDS_BYTES, stream, a); }
#else
    a.ph_lo = 0; a.ph_hi = N_PHASES; hipLaunchKernelGGL(fwd_kernel, dim3(grid), dim3(512), LDS_BYTES, stream, a);
#endif
}
```

```cpp
#include <hip/hip_runtime.h>
#include <cstdio>
#include <cstdint>
#define LAS __attribute__((address_space(3)))
typedef unsigned short bf16_t;
typedef short bf16x8 __attribute__((ext_vector_type(8)));
typedef float f32x2 __attribute__((ext_vector_type(2)));
typedef float f32x4 __attribute__((ext_vector_type(4)));
typedef float f32x16 __attribute__((ext_vector_type(16)));
typedef unsigned u32x2 __attribute__((ext_vector_type(2)));
typedef unsigned u32x4 __attribute__((ext_vector_type(4)));
typedef __bf16 bf16x2_t __attribute__((ext_vector_type(2)));

#ifndef MK_PER_PHASE
#define MK_PER_PHASE 0
#endif

constexpr int D = 1024, NB = 32, SEQ = 2048, CTXL = 256, TPB = SEQ + CTXL  ;
constexpr int MALL = NB * TPB  , MLAT = NB * SEQ  , MCTX = NB * CTXL  ;
constexpr int EVC = 4512, EVP = 4608;
constexpr int C_R = 0, C_K = 512, C_V = 1024, C_XWF = 1536, C_XWB = 1600, C_XAF = 1664, C_XAB = 1728, C_XG = 1792, C_Z = 1920, C_XBC = 2944, C_DT = 4480;
constexpr int MIXD = 1536;
constexpr int NEXP = 64, EFF = 256, CAP = MALL;
constexpr int MLAC = 672, MLAP = 768;
constexpr float NORM_EPS = 1e-6f;

__device__ __forceinline__ unsigned pk2(float lo, float hi) { f32x2 v = {lo, hi}; bf16x2_t b = __builtin_convertvector(v, bf16x2_t); return __builtin_bit_cast(unsigned, b); }
__device__ __forceinline__ bf16_t f2bf(float f) { return (bf16_t)(pk2(f, 0.f) & 0xffffu); }
__device__ __forceinline__ float bf2f(bf16_t b) { return __uint_as_float(((unsigned)b) << 16); }
__device__ __forceinline__ float bflo(unsigned w) { return __uint_as_float(w << 16); }
__device__ __forceinline__ float bfhi(unsigned w) { return __uint_as_float(w & 0xffff0000u); }
#define DPP_ADD(v, ctrl) v += __int_as_float(__builtin_amdgcn_update_dpp(0, __float_as_int(v), ctrl, 0xf, 0xf, true))
__device__ __forceinline__ float rowsum4(float v0, float v1, float v2, float v3) {
    auto s0 = __builtin_amdgcn_permlane32_swap(__float_as_uint(v0), __float_as_uint(v2), false, false); const float c = __uint_as_float(s0[0]) + __uint_as_float(s0[1]);
    auto s1 = __builtin_amdgcn_permlane32_swap(__float_as_uint(v1), __float_as_uint(v3), false, false); const float d = __uint_as_float(s1[0]) + __uint_as_float(s1[1]);
    auto s2 = __builtin_amdgcn_permlane16_swap(__float_as_uint(c), __float_as_uint(d), false, false); float r = __uint_as_float(s2[0]) + __uint_as_float(s2[1]);
    DPP_ADD(r, 0xB1); DPP_ADD(r, 0x4E); DPP_ADD(r, 0x141); DPP_ADD(r, 0x140);
    return r;
}
__device__ __forceinline__ float wave_sum(float v) {
    DPP_ADD(v, 0xB1); DPP_ADD(v, 0x4E); DPP_ADD(v, 0x141); DPP_ADD(v, 0x140);
    const int iv = __float_as_int(v);
    const float r0 = __int_as_float(__builtin_amdgcn_readlane(iv, 0)), r1 = __int_as_float(__builtin_amdgcn_readlane(iv, 16)), r2 = __int_as_float(__builtin_amdgcn_readlane(iv, 32)), r3 = __int_as_float(__builtin_amdgcn_readlane(iv, 48));
    return (r0 + r1) + (r2 + r3);
}
__device__ __forceinline__ float sigmoidf_(float x) { return __builtin_amdgcn_rcpf(1.f + __expf(-x)); }
__device__ __forceinline__ float siluf_(float x) { return x * __builtin_amdgcn_rcpf(1.f + __expf(-x)); }
__device__ __forceinline__ float softplusf_(float x) { return x > 20.f ? x : __logf(1.f + __expf(x)); }
__device__ __forceinline__ float tanhf_(float x) { const float e = __expf(2.f * x); return 1.f - 2.f * __builtin_amdgcn_rcpf(e + 1.f); }
__device__ __forceinline__ void unpack8(const u32x4 w, float (&o)[8]) { o[0] = bflo(w.x); o[1] = bfhi(w.x); o[2] = bflo(w.y); o[3] = bfhi(w.y); o[4] = bflo(w.z); o[5] = bfhi(w.z); o[6] = bflo(w.w); o[7] = bfhi(w.w); }
__device__ __forceinline__ int opaque_s(int x) { asm volatile("" : "+s"(x)); return x; }
__device__ __forceinline__ int opaque(int x) { asm volatile("" : "+v"(x)); return x; }
#define LBAR() asm volatile("s_waitcnt lgkmcnt(0)\n\ts_barrier" ::: "memory")
__device__ __forceinline__ int crow(int r, int hi) { return (r & 3) + 8 * (r >> 2) + 4 * hi; }

#define XB_TMO      128
#define XB_XCNT(j)  (256  + 64 * (j))
#define XB_XSUB(j)  (1280 + 64 * (j))
#define XB_XGEN(j)  (2304 + 64 * (j))
#define XB_TOP      3328
#define XB_TOPGEN   3392
#define XCD_BAR_WORDS 3456
#define XB_SPIN_CAP (1u << 18)
__device__ __forceinline__ unsigned xb_ld(unsigned* p)              { return __hip_atomic_load(p, __ATOMIC_RELAXED, __HIP_MEMORY_SCOPE_AGENT); }
__device__ __forceinline__ unsigned xb_add(unsigned* p, unsigned v) { return __hip_atomic_fetch_add(p, v, __ATOMIC_RELAXED, __HIP_MEMORY_SCOPE_AGENT); }
__device__ __forceinline__ unsigned xb_xcc_id() { return (unsigned)__builtin_amdgcn_s_getreg((3 << 11) | 20) & 0xFu; }
#define XB_SPIN(cond, bar) do { unsigned _sp = 0; while (cond) { __builtin_amdgcn_s_sleep(1); \
    if ((++_sp & 255u) == 0u) { if (xb_ld(&(bar)[XB_TMO])) break; if (_sp > XB_SPIN_CAP) { atomicAdd(&(bar)[XB_TMO], 1u); break; } } } } while (0)
struct XcdBarrier { unsigned* bar; unsigned x; volatile LAS unsigned* st; };
__device__ __forceinline__ XcdBarrier xcd_barrier_post(unsigned* bar, volatile LAS unsigned* st) {
    XcdBarrier b; b.bar = bar; b.x = xb_xcc_id(); b.st = st;
    if (threadIdx.x == 0) (void)xb_add(&bar[XB_XCNT(b.x)], 1u);
    return b;
}
__device__ __forceinline__ void xcd_barrier_complete(unsigned* bar, unsigned x, unsigned& nloc, unsigned& nx) {
    const unsigned G = gridDim.x * gridDim.y * gridDim.z;
    unsigned sum, cnt, mine, sp = 0u;
    for (;;) {
        sum = 0u; cnt = 0u; mine = 0u;
#pragma unroll
        for (unsigned j = 0; j < 16; ++j) { const unsigned c = xb_ld(&bar[XB_XCNT(j)]); sum += c; cnt += (c > 0u) ? 1u : 0u; mine = (j == x) ? c : mine; }
        if (sum == G) break;
        __builtin_amdgcn_s_sleep(1);
        if ((++sp & 255u) == 0u) { if (xb_ld(&bar[XB_TMO])) break; if (sp > XB_SPIN_CAP) { atomicAdd(&bar[XB_TMO], 1u); break; } }
    }
    nloc = mine > 0u ? mine : 1u; nx = cnt > 0u ? cnt : 1u;
}
__device__ __forceinline__ void xcd_barrier(const XcdBarrier& b) {
    asm volatile("s_waitcnt vmcnt(0)" ::: "memory");
    __syncthreads();
    if (threadIdx.x == 0) {
        unsigned* bar = b.bar;
        __builtin_amdgcn_s_waitcnt(0);
        unsigned nloc = b.st[0], nx = b.st[1];
        if (nloc == 0u) { xcd_barrier_complete(bar, b.x, nloc, nx); b.st[0] = nloc; b.st[1] = nx; }
        const unsigned old = xb_add(&bar[XB_XSUB(b.x)], 1u);
        const unsigned gen = old / nloc;
        if (old + 1u == (gen + 1u) * nloc) {
            __builtin_amdgcn_fence(__ATOMIC_RELEASE, "agent");
            asm volatile("s_waitcnt vmcnt(0)" ::: "memory");
            const unsigned og = xb_add(&bar[XB_TOP], 1u);
            const unsigned tg = og / nx;
            if (og + 1u == (tg + 1u) * nx) xb_add(&bar[XB_TOPGEN], 1u);
            else XB_SPIN(xb_ld(&bar[XB_TOPGEN]) == tg, bar);
            __builtin_amdgcn_fence(__ATOMIC_ACQUIRE, "agent");
            xb_add(&bar[XB_XGEN(b.x)], 1u);
            asm volatile("s_waitcnt vmcnt(0)" ::: "memory");
        } else {
            XB_SPIN(xb_ld(&bar[XB_XGEN(b.x)]) == gen, bar);
            __builtin_amdgcn_fence(__ATOMIC_ACQUIRE, "agent");
            asm volatile("s_waitcnt vmcnt(0)" ::: "memory");
        }
    }
    __syncthreads();
}

namespace pg8 {
constexpr int BM = 256, BK = 64, HALF = 128, HTB = HALF * BK * 2, STAGE_BYTES = 8 * HTB, NXCD = 8, WGM = 8;
__host__ __device__ __forceinline__ int lds_byte(int r, int c) { const int st = (r >> 4) * 2 + (c >> 5), rr = r & 15, cc = c & 31, ob = rr * 64 + cc * 2; return st * 1024 + (ob ^ (((ob >> 9) & 1) << 5)); }
__host__ __device__ __forceinline__ void stage_rc(int b, int& R, int& C) { const int st = b / 1024, sb = b % 1024, swz = sb ^ (((sb >> 9) & 1) << 5); R = (st >> 1) * 16 + swz / 64; C = (st & 1) * 32 + (swz % 64) / 2; }
__host__ __device__ __forceinline__ int perm32(int rho) { const int n = rho >> 4, i = rho & 15; return 8 * (i >> 2) + 4 * n + (i & 3); }

struct Unit { int ar, br, cr, cc, e, nv; };
struct Gemm { const bf16_t* A; const bf16_t* Bt; int lda, ldb, K; const int* glist; };

__device__ __forceinline__ bool tile_order(int nM, int nN, long L, int& pm, int& pn) {
    const int nwg = nM * nN; if (L >= nwg) return false;
    int wgid = (int)L; { const int q = nwg / NXCD, r = nwg % NXCD, xcd = wgid % NXCD, off = wgid / NXCD; wgid = (xcd < r ? xcd * (q + 1) : r * (q + 1) + (xcd - r) * q) + off; }
    const int nig = WGM * nN, gid = wgid / nig, fm = gid * WGM, gsz = (nM - fm) < WGM ? (nM - fm) : WGM;
    pm = fm + ((wgid % nig) % gsz); pn = (wgid % nig) / gsz; return true;
}
struct DenseSched {
    int nM, nN, G, c;
    __device__ __forceinline__ void init(int M, int N, int G_, int c_) { nM = M / BM; nN = N / BM; G = G_; c = c_; }
    __device__ __forceinline__ bool next(int i, Unit& u) const {
        int pm, pn; if (!tile_order(nM, nN, (long)i * G + c, pm, pn)) return false;
        u.ar = pm * BM; u.br = pn * BM; u.cr = pm * BM; u.cc = pn * BM; u.e = 0; u.nv = BM; return true;
    }
};

template <class Epi, class Sched, bool GATHER, bool ALIGN_EPI = true, bool SP2 = true>
__device__ __forceinline__ void gemm_phase(LAS unsigned char* lds, const Gemm g, const Sched& S, const Epi& E) {
    const int tid = opaque((int)threadIdx.x), wid = __builtin_amdgcn_readfirstlane(tid >> 6), lane = tid & 63, wr = wid >> 2, wc = wid & 3, fr = lane & 15, fq = lane >> 4;
    const int K = opaque_s(g.K), nt = K / BK;
    unsigned voffA[2], voffBh[2][2];
#pragma unroll
    for (int i = 0; i < 2; ++i) { int R, C; stage_rc(tid * 16 + i * 8192, R, C);
        voffA[i] = (unsigned)(R * g.lda + C) * 2u;
#pragma unroll
        for (int h = 0; h < 2; ++h) { int Rb;
            if (Epi::PERM == 2) Rb = 64 * (R >> 5) + 16 * ((R >> 2) & 3) + 8 * h + 4 * ((R >> 4) & 1) + (R & 3);
            else Rb = h * HALF + (Epi::PERM == 1 ? ((R & ~31) + perm32(R & 31)) : R);
            voffBh[h][i] = (unsigned)(Rb * g.ldb + C) * 2u; } }
    const size_t kstep = (size_t)(BK * 2);
    const size_t hstepA = (size_t)HALF * g.lda * 2;
    const unsigned ldsw = (unsigned)wid * 1024u;
    const int aoff = lds_byte(wr * 64 + fr, fq * 8), boff = lds_byte(wc * 32 + fr, fq * 8);
#define PG8_SA(b, h) (((b) * 2 + (h)) * HTB)
#define PG8_SB(b, h) ((4 + (b) * 2 + (h)) * HTB)
#define PG8_STAGE(bufoff, gbase, voff) do { _Pragma("unroll") for (int _i = 0; _i < 2; ++_i) \
        __builtin_amdgcn_global_load_lds((const unsigned*)((const char*)(gbase) + (voff)[_i]), (LAS unsigned*)(lds + (bufoff) + ldsw + _i * 8192), 16, 0, 0); } while (0)
#define PG8_STAGE_A(bufoff, ubase, h, goffsel) do { if constexpr (GATHER) { PG8_STAGE(bufoff, ubase, (goffsel)[h]); } else { PG8_STAGE(bufoff, (ubase) + (h) * hstepA, voffA); } } while (0)
#define PG8_LDA(dst, b, h) do { _Pragma("unroll") for (int m = 0; m < 4; ++m) _Pragma("unroll") for (int k = 0; k < 2; ++k) dst[m][k] = *(const LAS bf16x8*)(lds + PG8_SA(b, h) + aoff + m * 2048 + k * 1024); } while (0)
#define PG8_LDB(dst, b, h) do { _Pragma("unroll") for (int n = 0; n < 2; ++n) _Pragma("unroll") for (int k = 0; k < 2; ++k) dst[n][k] = *(const LAS bf16x8*)(lds + PG8_SB(b, h) + boff + n * 2048 + k * 1024); } while (0)
#define PG8_MMA(ai, bj, At, Bt) do { __builtin_amdgcn_s_setprio(1); _Pragma("unroll") for (int m = 0; m < 4; ++m) _Pragma("unroll") for (int n = 0; n < 2; ++n) _Pragma("unroll") for (int k = 0; k < 2; ++k) \
        acc[ai][bj][m][n] = __builtin_amdgcn_mfma_f32_16x16x32_bf16(Bt[n][k], At[m][k], acc[ai][bj][m][n], 0, 0, 0); __builtin_amdgcn_s_setprio(0); } while (0)
#define PG8_WAIT_V(n) asm volatile("s_waitcnt vmcnt(" #n ")" ::: "memory")
#define PG8_WAIT_L(n) asm volatile("s_waitcnt lgkmcnt(" #n ")" ::: "memory")
#define PG8_BAR __builtin_amdgcn_s_barrier()
#define PG8_SCHED __builtin_amdgcn_sched_barrier(0)
    Unit cur, nxt; int ui = 0;
    if (!S.next(0, cur)) return;
    f32x4 acc[2][2][4][2];
#pragma unroll
    for (int a = 0; a < 2; ++a)
#pragma unroll
        for (int b = 0; b < 2; ++b)
#pragma unroll
            for (int m = 0; m < 4; ++m)
#pragma unroll
                for (int n = 0; n < 2; ++n) acc[a][b][m][n] = (f32x4){0.f, 0.f, 0.f, 0.f};
    bf16x8 At[4][2], B0[2][2], B1[2][2];
    unsigned gcur[2][2], gnxt[2][2];
#define PG8_GLOAD(dst, u) do { const int _tz = opaque(tid); _Pragma("unroll") for (int _h = 0; _h < 2; ++_h) _Pragma("unroll") for (int _i = 0; _i < 2; ++_i) { int _R0, _C0; stage_rc(_tz * 16 + _i * 8192, _R0, _C0); \
        const int _R = _R0 + _h * HALF; const int _ix = g.glist[(size_t)(u).ar + (_R < (u).nv ? _R : 0)]; dst[_h][_i] = (unsigned)(_ix * g.lda + _C0) * 2u; } } while (0)
    const char* cA; const char* cB = (const char*)g.Bt + (size_t)cur.br * g.ldb * 2;
    if constexpr (GATHER) { cA = (const char*)g.A; PG8_GLOAD(gcur, cur); } else { cA = (const char*)g.A + (size_t)cur.ar * g.lda * 2; }
    if constexpr (SP2) {
        PG8_STAGE(PG8_SB(0, 0), cB, voffBh[0]); PG8_STAGE(PG8_SB(0, 1), cB, voffBh[1]); PG8_STAGE_A(PG8_SA(0, 0), cA, 0, gcur); PG8_STAGE_A(PG8_SA(0, 1), cA, 1, gcur);
        if (wr == 1) PG8_BAR;
        PG8_WAIT_V(2); PG8_BAR;
        PG8_STAGE(PG8_SB(1, 0), cB + kstep, voffBh[0]); PG8_STAGE_A(PG8_SA(1, 0), cA + kstep, 0, gcur); PG8_STAGE(PG8_SB(1, 1), cB + kstep, voffBh[1]);
        PG8_WAIT_V(6); PG8_BAR;
    } else {
    PG8_STAGE(PG8_SB(0, 0), cB, voffBh[0]); PG8_STAGE_A(PG8_SA(0, 0), cA, 0, gcur); PG8_STAGE(PG8_SB(0, 1), cB, voffBh[1]); PG8_STAGE_A(PG8_SA(0, 1), cA, 1, gcur);
    if (wr == 1) PG8_BAR;
    PG8_WAIT_V(4); PG8_BAR;
    PG8_STAGE(PG8_SB(1, 0), cB + kstep, voffBh[0]); PG8_STAGE_A(PG8_SA(1, 0), cA + kstep, 0, gcur); PG8_STAGE(PG8_SB(1, 1), cB + kstep, voffBh[1]);
    PG8_WAIT_V(6); PG8_BAR;
    }
    for (;;) {
        const bool has_next = S.next(ui + 1, nxt);
        const char* nA; const char* nB = has_next ? (const char*)g.Bt + (size_t)nxt.br * g.ldb * 2 : cB;
        if constexpr (GATHER) { nA = cA; if (has_next) { PG8_GLOAD(gnxt, nxt); } else {
#pragma unroll
                for (int _h = 0; _h < 2; ++_h)
#pragma unroll
                    for (int _i = 0; _i < 2; ++_i) gnxt[_h][_i] = gcur[_h][_i]; } }
        else { nA = has_next ? (const char*)g.A + (size_t)nxt.ar * g.lda * 2 : cA; }
        for (int t = 0; t < nt; t += 2) {
            const bool last = (t == nt - 2);
            const char* a1 = cA + (size_t)(t + 1) * kstep;
            const char* a2 = last ? nA : cA + (size_t)(t + 2) * kstep; const char* b2 = last ? nB : cB + (size_t)(t + 2) * kstep;
            const char* a3 = a2 + kstep; const char* b3 = b2 + kstep;
            unsigned g2[2][2];
            if constexpr (GATHER) {
#pragma unroll
                for (int _h = 0; _h < 2; ++_h)
#pragma unroll
                    for (int _i = 0; _i < 2; ++_i) g2[_h][_i] = last ? gnxt[_h][_i] : gcur[_h][_i]; }
            if constexpr (SP2) {
            PG8_LDB(B0, 0, 0); PG8_LDB(B1, 0, 1); PG8_SCHED; PG8_LDA(At, 0, 0); PG8_STAGE_A(PG8_SA(1, 1), a1, 1, gcur);
            PG8_WAIT_V(8); PG8_WAIT_L(0); PG8_BAR; PG8_MMA(0, 0, At, B0); PG8_MMA(0, 1, At, B1); PG8_BAR; PG8_SCHED;
            PG8_LDA(At, 0, 1); PG8_STAGE(PG8_SB(0, 0), b2, voffBh[0]); PG8_STAGE(PG8_SB(0, 1), b2, voffBh[1]); PG8_STAGE_A(PG8_SA(0, 0), a2, 0, g2);
            PG8_WAIT_V(8); PG8_WAIT_L(0); PG8_BAR; PG8_MMA(1, 0, At, B0); PG8_MMA(1, 1, At, B1); PG8_BAR; PG8_SCHED;
            PG8_LDB(B0, 1, 0); PG8_LDB(B1, 1, 1); PG8_SCHED; PG8_LDA(At, 1, 0); PG8_STAGE_A(PG8_SA(0, 1), a2, 1, g2);
            PG8_WAIT_V(8); PG8_WAIT_L(0); PG8_BAR; PG8_MMA(0, 0, At, B0); PG8_MMA(0, 1, At, B1); PG8_BAR; PG8_SCHED;
            PG8_LDA(At, 1, 1); PG8_STAGE(PG8_SB(1, 0), b3, voffBh[0]); PG8_STAGE(PG8_SB(1, 1), b3, voffBh[1]); PG8_STAGE_A(PG8_SA(1, 0), a3, 0, g2);
            PG8_WAIT_V(8); PG8_WAIT_L(0); PG8_BAR; PG8_MMA(1, 0, At, B0); PG8_MMA(1, 1, At, B1); PG8_BAR; PG8_SCHED;
            } else {
            PG8_LDB(B0, 0, 0); PG8_SCHED; PG8_LDA(At, 0, 0); PG8_STAGE_A(PG8_SA(1, 1), a1, 1, gcur);
            PG8_WAIT_L(8); PG8_BAR; PG8_WAIT_L(0); PG8_MMA(0, 0, At, B0); PG8_BAR; PG8_SCHED;
            PG8_LDB(B1, 0, 1); PG8_STAGE(PG8_SB(0, 0), b2, voffBh[0]);
            PG8_BAR; PG8_WAIT_L(0); PG8_MMA(0, 1, At, B1); PG8_BAR;
            PG8_LDA(At, 0, 1); PG8_STAGE_A(PG8_SA(0, 0), a2, 0, g2);
            PG8_BAR; PG8_WAIT_L(0); PG8_MMA(1, 0, At, B0); PG8_BAR; PG8_SCHED;
            PG8_STAGE(PG8_SB(0, 1), b2, voffBh[1]);
            PG8_WAIT_V(6); PG8_BAR; PG8_MMA(1, 1, At, B1); PG8_BAR;
            PG8_LDB(B0, 1, 0); PG8_SCHED; PG8_LDA(At, 1, 0); PG8_STAGE_A(PG8_SA(0, 1), a2, 1, g2);
            PG8_WAIT_L(8); PG8_BAR; PG8_WAIT_L(0); PG8_MMA(0, 0, At, B0); PG8_BAR; PG8_SCHED;
            PG8_LDB(B1, 1, 1); PG8_STAGE(PG8_SB(1, 0), b3, voffBh[0]);
            PG8_BAR; PG8_WAIT_L(0); PG8_MMA(0, 1, At, B1); PG8_BAR;
            PG8_LDA(At, 1, 1); PG8_STAGE_A(PG8_SA(1, 0), a3, 0, g2);
            PG8_BAR; PG8_WAIT_L(0); PG8_MMA(1, 0, At, B0); PG8_BAR; PG8_SCHED;
            PG8_STAGE(PG8_SB(1, 1), b3, voffBh[1]);
            PG8_WAIT_V(6); PG8_BAR; PG8_MMA(1, 1, At, B1); PG8_BAR;
                    }
        }
        if constexpr (ALIGN_EPI) { if (wr == 0) PG8_BAR; }
        E(acc, cur, wr, wc, fr, fq);
        if (!has_next) break;
#pragma unroll
        for (int a = 0; a < 2; ++a)
#pragma unroll
            for (int b = 0; b < 2; ++b)
#pragma unroll
                for (int m = 0; m < 4; ++m)
#pragma unroll
                    for (int n = 0; n < 2; ++n) acc[a][b][m][n] = (f32x4){0.f, 0.f, 0.f, 0.f};
        cur = nxt; cA = nA; cB = nB; ++ui;
        if constexpr (GATHER) {
#pragma unroll
            for (int _h = 0; _h < 2; ++_h)
#pragma unroll
                for (int _i = 0; _i < 2; ++_i) gcur[_h][_i] = gnxt[_h][_i]; }
        if constexpr (ALIGN_EPI) { if (wr == 1) PG8_BAR; }
    }
    PG8_WAIT_V(0);
    if constexpr (!ALIGN_EPI) { if (wr == 0) PG8_BAR; }
    PG8_BAR;
#undef PG8_SA
#undef PG8_SB
#undef PG8_STAGE
#undef PG8_STAGE_A
#undef PG8_LDA
#undef PG8_LDB
#undef PG8_MMA
#undef PG8_WAIT_V
#undef PG8_WAIT_L
#undef PG8_BAR
#undef PG8_SCHED
#undef PG8_GLOAD
}
}

constexpr size_t MiB = 1u << 20;
constexpr size_t WS_CTL = 0, CTL_BYTES = 1 * MiB;
constexpr int CW_BAR = 0, CW_CNT = 4096  , CW_DIAG = 12288;
constexpr size_t WS_MODS = 1 * MiB;
constexpr size_t WS_ROPE = 3 * MiB;
constexpr size_t WS_WIN = 4 * MiB, WS_WOUT = 13 * MiB, WS_WMLA = 16 * MiB, WS_WQ = 18 * MiB, WS_WK = 20 * MiB, WS_WV = 21 * MiB, WS_WO = 22 * MiB;
constexpr size_t WS_ROUT = 24 * MiB  , WS_W2T = 25 * MiB  , WS_A2T = 25 * MiB + 256 * 1024, WS_G2T = 25 * MiB + 512 * 1024  ;
constexpr size_t WS_W13 = 26 * MiB;
constexpr size_t WS_W2E = 156 * MiB;
constexpr size_t WS_BSUM = 221 * MiB;
constexpr size_t WS_COLS = 224 * MiB;
constexpr size_t WS_XL = 224 * MiB, WS_XC = 480 * MiB;
constexpr size_t WS_HID = 512 * MiB;
constexpr size_t WS_LIST = 766 * MiB;
constexpr size_t WS_TSEL = 221 * MiB;
constexpr size_t WS_TGATE = 4 * MiB;
constexpr size_t WS_TOK = 806 * MiB;
constexpr size_t WS_YB = 776 * MiB;
constexpr int YSPLIT = 262144;
constexpr size_t WS_HA1 = 512 * MiB;
constexpr size_t WS_CQN = 728 * MiB, WS_CKVN = 776 * MiB, WS_KR = 832 * MiB;
constexpr size_t WS_Q = 512 * MiB;
constexpr size_t WS_O = 704 * MiB;
constexpr size_t WS_KN = 880 * MiB;
constexpr size_t WS_END = 1024 * MiB;

struct Args { const float* in[42]; float* out; unsigned char* ws; int ph_lo, ph_hi; };

struct Frame {
    LAS unsigned char* lds;
    int tid, lane, wave, G, bid;
    unsigned char* ws; unsigned char* dout;
};

enum { I_X = 0, I_C, I_CTX, I_CCTX, I_ADAW, I_ADAB, I_NMIX, I_NFFN, I_EVWIN, I_EVWOUT, I_RWMU, I_RWW0, I_RWW2, I_RWA0, I_RWA2, I_RWG2, I_RWKK, I_RWKA, I_RWRK, I_RWGNW, I_RWGNB,
       I_CONVW, I_CONVB, I_DTB, I_ALOG, I_SSMD, I_SSMNW, I_MLAWIN, I_MLAQN, I_MLAQUP, I_MLAKVN, I_MLAKVUP, I_MLAWOUT, I_ROUTW, I_ROUTB, I_EW1, I_EW3, I_EW2, I_SW1, I_SW3, I_SW2, I_FNORM };

struct EpiBf16 {
    static constexpr int PERM = 2;
    bf16_t* O; int ldc;
    __device__ __forceinline__ void operator()(const f32x4 (&acc)[2][2][4][2], const pg8::Unit& u, int wr, int wc, int fr, int fq) const {
#pragma unroll
        for (int ai = 0; ai < 2; ++ai)
#pragma unroll
            for (int m = 0; m < 4; ++m) { const int rl = ai * 128 + wr * 64 + m * 16 + fr; if (rl < u.nv) { bf16_t* rowp = O + (size_t)(u.cr + rl) * ldc + u.cc + wc * 64 + 16 * fq;
#pragma unroll
                for (int bj = 0; bj < 2; ++bj) { const f32x4 v0 = acc[ai][bj][m][0], v1 = acc[ai][bj][m][1];
                    u32x4 w; w.x = pk2(v0[0], v0[1]); w.y = pk2(v0[2], v0[3]); w.z = pk2(v1[0], v1[1]); w.w = pk2(v1[2], v1[3]);
                    *(u32x4*)(rowp + bj * 8) = w; } } }
    }
};
struct EpiF32 {
    static constexpr int PERM = 0;
    float* C; int ldc;
    __device__ __forceinline__ void operator()(const f32x4 (&acc)[2][2][4][2], const pg8::Unit& u, int wr, int wc, int fr, int fq) const {
#pragma unroll
        for (int ai = 0; ai < 2; ++ai)
#pragma unroll
            for (int m = 0; m < 4; ++m) { float* rowp = C + (size_t)(u.cr + ai * 128 + wr * 64 + m * 16 + fr) * ldc + u.cc + wc * 32 + 4 * fq;
#pragma unroll
                for (int bj = 0; bj < 2; ++bj)
#pragma unroll
                    for (int n = 0; n < 2; ++n) *(f32x4*)(rowp + bj * 128 + n * 16) = acc[ai][bj][m][n]; }
    }
};
struct EpiGlu {
    static constexpr int PERM = 1;
    bf16_t* H;
    __device__ __forceinline__ void operator()(const f32x4 (&acc)[2][2][4][2], const pg8::Unit& u, int wr, int wc, int fr, int fq) const {
#pragma unroll
        for (int ai = 0; ai < 2; ++ai)
#pragma unroll
            for (int m = 0; m < 4; ++m) { const int rl = ai * 128 + wr * 64 + m * 16 + fr; if (rl < u.nv) {
                float o[8];
#pragma unroll
                for (int n = 0; n < 2; ++n)
#pragma unroll
                    for (int j = 0; j < 4; ++j) { const float a = acc[ai][0][m][n][j], b = acc[ai][1][m][n][j]; o[n * 4 + j] = siluf_(a) * b; }
                u32x4 w; w.x = pk2(o[0], o[1]); w.y = pk2(o[2], o[3]); w.z = pk2(o[4], o[5]); w.w = pk2(o[6], o[7]);
                *(u32x4*)(H + (size_t)(u.cr + rl) * 256 + (u.cc >> 1) + wc * 32 + 8 * fq) = w; } }
    }
};
template <int MODE> struct EpiResid {
    static constexpr int PERM = 0;
    const float* x; const float* ctx; bf16_t* xl; bf16_t* xc; const float* mods;
    __device__ __forceinline__ void operator()(const f32x4 (&acc)[2][2][4][2], const pg8::Unit& u, int wr, int wc, int fr, int fq) const {
        fr = opaque(fr); fq = opaque(fq);
        const float* base = nullptr; bf16_t* out; int mr;
        if (MODE == 0) { const int pm = u.cr >> 8, b = pm / 9, j = pm % 9;
            if (j == 0) { base = ctx + (size_t)(b * CTXL) * D; out = xc + (size_t)(b * CTXL) * D; mr = 32; }
            else { const size_t r0 = (size_t)(b * SEQ + (j - 1) * 256); base = x + r0 * D; out = xl + r0 * D; mr = b; } }
        else { out = xl + (size_t)u.cr * D; mr = u.cr / SEQ; }
        const float* gv = mods + (size_t)mr * 6144 + 2 * D + u.cc + wc * 32 + 4 * fq;
        f32x4 gt[2][2];
#pragma unroll
        for (int bj = 0; bj < 2; ++bj)
#pragma unroll
            for (int n = 0; n < 2; ++n) gt[bj][n] = *(const f32x4*)(gv + bj * 128 + n * 16);
#pragma unroll
        for (int ai = 0; ai < 2; ++ai)
#pragma unroll
            for (int m = 0; m < 4; ++m) { const size_t off = (size_t)(ai * 128 + wr * 64 + m * 16 + fr) * D + u.cc + wc * 32 + 4 * fq;
#pragma unroll
                for (int bj = 0; bj < 2; ++bj)
#pragma unroll
                    for (int n = 0; n < 2; ++n) { f32x4 b4;
                        if (MODE == 0) b4 = *(const f32x4*)(base + off + bj * 128 + n * 16);
                        else { const u32x2 o2 = *(const u32x2*)(out + off + bj * 128 + n * 16); b4 = (f32x4){bflo(o2.x), bfhi(o2.x), bflo(o2.y), bfhi(o2.y)}; }
                        const f32x4 r4 = b4 + gt[bj][n] * acc[ai][bj][m][n]; u32x2 w2; w2.x = pk2(r4[0], r4[1]); w2.y = pk2(r4[2], r4[3]);
                        *(u32x2*)(out + off + bj * 128 + n * 16) = w2; } }
    }
};
struct EpiQ {
    static constexpr int PERM = 0;
    bf16_t* Q; const float* rope;
    __device__ __forceinline__ void operator()(const f32x4 (&acc)[2][2][4][2], const pg8::Unit& u, int wr, int wc, int fr, int fq) const {
        const float qs = 0.10206207261596577f * 1.4426950408889634f;
#pragma unroll
        for (int bj = 0; bj < 2; ++bj) { const int c0 = u.cc + bj * 128 + wc * 32; const bool isr = __builtin_amdgcn_readfirstlane((c0 % 96) == 64);
#pragma unroll
            for (int ai = 0; ai < 2; ++ai)
#pragma unroll
                for (int m = 0; m < 4; ++m) { fr = opaque(fr); fq = opaque(fq); const int row = u.cr + ai * 128 + wr * 64 + m * 16 + fr;
                    f32x4 a = acc[ai][bj][m][0], b = acc[ai][bj][m][1];
                    if (isr) { const int t = row & (SEQ - 1); const f32x4 cs = *(const f32x4*)(rope + t * 16 + 4 * fq), sn = *(const f32x4*)(rope + SEQ * 16 + t * 16 + 4 * fq);
                        const f32x4 a2 = a * cs - b * sn, b2 = a * sn + b * cs; a = a2; b = b2; }
                    a *= qs; b *= qs;
                    bf16_t* p = Q + (size_t)row * 1536 + c0 + 4 * fq;
                    u32x2 w0, w1; w0.x = pk2(a[0], a[1]); w0.y = pk2(a[2], a[3]); w1.x = pk2(b[0], b[1]); w1.y = pk2(b[2], b[3]);
                    *(u32x2*)p = w0; *(u32x2*)(p + 16) = w1; } }
    }
};
constexpr float Y8_SCALE = 64.f, Y8_INV = 1.f / 64.f;
__device__ __forceinline__ unsigned pk4_fp8(float a, float b, float c, float d) {
    a = __builtin_amdgcn_fmed3f(a * Y8_SCALE, -440.f, 440.f); b = __builtin_amdgcn_fmed3f(b * Y8_SCALE, -440.f, 440.f); c = __builtin_amdgcn_fmed3f(c * Y8_SCALE, -440.f, 440.f); d = __builtin_amdgcn_fmed3f(d * Y8_SCALE, -440.f, 440.f);
    int w = __builtin_amdgcn_cvt_pk_fp8_f32(a, b, 0, false); w = __builtin_amdgcn_cvt_pk_fp8_f32(c, d, w, true); return (unsigned)w; }
struct EpiMoeDown {
    static constexpr int PERM = 2;
    unsigned char* ya; unsigned char* yb;
    __device__ __forceinline__ void operator()(const f32x4 (&acc)[2][2][4][2], const pg8::Unit& u, int wr, int wc, int fr, int fq) const {
        fr = opaque(fr); fq = opaque(fq);
        const int cl = u.cc + wc * 64 + 16 * fq;
#pragma unroll
        for (int ai = 0; ai < 2; ++ai)
#pragma unroll
            for (int m = 0; m < 4; ++m) { const int rl = ai * 128 + wr * 64 + m * 16 + fr; if (rl < u.nv) {
                const int row = u.cr + rl;
                unsigned char* rowp = (row < YSPLIT ? ya + (size_t)row * 1024 : yb + (size_t)(row - YSPLIT) * 1024) + cl;
                u32x4 w;
                { const f32x4 a0 = acc[ai][0][m][0], a1 = acc[ai][0][m][1], b0 = acc[ai][1][m][0], b1 = acc[ai][1][m][1];
                  w.x = pk4_fp8(a0[0], a0[1], a0[2], a0[3]); w.y = pk4_fp8(a1[0], a1[1], a1[2], a1[3]); w.z = pk4_fp8(b0[0], b0[1], b0[2], b0[3]); w.w = pk4_fp8(b1[0], b1[1], b1[2], b1[3]); }
                *(u32x4*)rowp = w; } }
    }
};

constexpr int RING_OFF = 0, MISC_OFF = 131072, LDS_BYTES = 147456;
#define LDS_WAIT() asm volatile("s_waitcnt lgkmcnt(0)" ::: "memory")
__device__ __forceinline__ float* ws_f32(const Frame& F, size_t off) { return (float*)(F.ws + off); }
__device__ __forceinline__ bf16_t* ws_bf(const Frame& F, size_t off) { return (bf16_t*)(F.ws + off); }

__device__ __forceinline__ void p0_mods(const Frame& F, const Args& a) {
  for (int cblk = F.bid; cblk < 192; cblk += F.G) {
    LAS float* S = (LAS float*)F.lds;
    for (int i = F.tid; i < 33 * 1024; i += 512) { const int r = i >> 10, d = i & 1023; const float c = (r < 32) ? a.in[I_C][r * 1024 + d] : a.in[I_CCTX][d]; S[i] = siluf_(c); }
    __syncthreads();
    const int col = F.tid & 63, dp = F.tid >> 6, cflat = cblk * 64 + col, layer = cflat / 6144, n = cflat % 6144;
    const float* W = a.in[I_ADAW] + (size_t)layer * 1024 * 6144 + n;
    float acc[33];
#pragma unroll
    for (int r = 0; r < 33; ++r) acc[r] = 0.f;
    for (int d4 = 0; d4 < 32; ++d4) { const int d = dp * 128 + d4 * 4;
        const float w0 = W[(size_t)(d + 0) * 6144], w1 = W[(size_t)(d + 1) * 6144], w2 = W[(size_t)(d + 2) * 6144], w3 = W[(size_t)(d + 3) * 6144];
#pragma unroll
        for (int r = 0; r < 33; ++r) { const f32x4 s4 = *(const LAS f32x4*)(S + r * 1024 + d); acc[r] += s4[0] * w0 + s4[1] * w1 + s4[2] * w2 + s4[3] * w3; } }
    __syncthreads();
    LAS float* Pp = (LAS float*)F.lds;
#pragma unroll
    for (int r = 0; r < 33; ++r) Pp[(dp * 33 + r) * 64 + col] = acc[r];
    __syncthreads();
    float* mods = ws_f32(F, WS_MODS);
    for (int i = F.tid; i < 33 * 64; i += 512) { const int r = i >> 6, c = i & 63; float s = 0.f;
#pragma unroll
        for (int q = 0; q < 8; ++q) s += Pp[(q * 33 + r) * 64 + c];
        const int cf = cblk * 64 + c, ly = cf / 6144, nn = cf % 6144;
        mods[((size_t)ly * 33 + r) * 6144 + nn] = s + a.in[I_ADAB][ly * 6144 + nn]; }
    __syncthreads();
  }
}
__device__ __forceinline__ void conv_item(const float* W, int N, int k0, int n0, bf16_t* dst, int rowbase, int ldd, LAS float* scr, int lane) {
#pragma unroll 8
    for (int i = 0; i < 32; ++i) { const int kk = 2 * i + (lane >> 5); scr[kk * 33 + (lane & 31)] = W[(size_t)(k0 + kk) * N + n0 + (lane & 31)]; }
    LDS_WAIT(); asm volatile("" ::: "memory");
    const int c = lane & 7;
#pragma unroll
    for (int j = 0; j < 4; ++j) { const int n = (lane >> 3) + 8 * j; const LAS float* s = scr + (8 * c) * 33 + n;
        u32x4 o; o.x = pk2(s[0 * 33], s[1 * 33]); o.y = pk2(s[2 * 33], s[3 * 33]); o.z = pk2(s[4 * 33], s[5 * 33]); o.w = pk2(s[6 * 33], s[7 * 33]);
        *(u32x4*)(dst + (size_t)(rowbase + n) * ldd + k0 + 8 * c) = o; }
    LDS_WAIT(); asm volatile("" ::: "memory");
}
template <int MODE> __device__ __forceinline__ void conv_job(const Frame& F, const float* src, int K, int N, size_t sstride, size_t dst_off, size_t dstride_bytes, int ldd, bool expert_batches, int r, LAS float* scr) {
    const int nkb = K / 64, nnb = N / 32, per = nkb * nnb, b = r / per, rr = r % per, kb = rr / nnb, nb = rr % nnb, n0 = nb * 32;
    size_t doff = dst_off;
    if (expert_batches) doff += (size_t)((b >> 6) * 65 + (b & 63)) * dstride_bytes; else doff += (size_t)b * dstride_bytes;
    int rowbase = n0;
    if (MODE == 1 || MODE == 2) rowbase = (n0 >> 7) * 256 + (MODE == 2 ? 128 : 0) + (n0 & 127);
    if (MODE == 3) { const int h = n0 >> 7, j0 = n0 & 127; if (j0 < 64) rowbase = h * 64 + j0; else { rowbase = h * 64 + j0 - 64; doff = WS_WV; } }
    conv_item(src + (size_t)b * sstride, N, kb * 64, n0, (bf16_t*)(F.ws + doff), rowbase, ldd, scr, F.lane);
}
__device__ __forceinline__ void p0_convert(const Frame& F, const Args& a) {
    LAS float* scr = (LAS float*)(F.lds + F.wave * 16384);
    const int gw = F.bid * 8 + F.wave, NGW = F.G * 8;
    constexpr int N0 = 16 * 141, N1 = 24 * 32, N2 = 2 * 16, N3 = 2 * 16, N4 = 2 * 16, N5 = 16 * 21, N6 = 6 * 48, N7 = 4 * 64, N8 = 16 * 32, N9 = 2 * 16 * 2,
                  N10 = 128 * 16 * 8, N12 = 128 * 4 * 32, N13 = 2 * 16 * 8, N15 = 2 * 4 * 32; (void)N10; (void)N12; (void)N13; (void)N15;
    constexpr int NITEMS = N0 + N1 + N2 + N3 + N4 + N5 + N6 + N7 + N8 + N9;
    for (int it = gw; it < NITEMS; it += NGW) {
        int r = it;
        if (r < N0) { conv_job<0>(F, a.in[I_EVWIN], 1024, EVC, 0, WS_WIN, 0, 1024, false, r, scr); continue; } r -= N0;
        if (r < N1) { conv_job<0>(F, a.in[I_EVWOUT], 1536, 1024, 0, WS_WOUT, 0, 1536, false, r, scr); continue; } r -= N1;
        if (r < N2) { conv_job<0>(F, a.in[I_RWW2], 64, 512, 64 * 512, WS_W2T, 512 * 64 * 2, 64, false, r, scr); continue; } r -= N2;
        if (r < N3) { conv_job<0>(F, a.in[I_RWA2], 64, 512, 64 * 512, WS_A2T, 512 * 64 * 2, 64, false, r, scr); continue; } r -= N3;
        if (r < N4) { conv_job<0>(F, a.in[I_RWG2], 128, 512, 0, WS_G2T, 0, 128, false, r, scr); continue; } r -= N4;
        if (r < N5) { conv_job<0>(F, a.in[I_MLAWIN], 1024, MLAC, 0, WS_WMLA, 0, 1024, false, r, scr); continue; } r -= N5;
        if (r < N6) { conv_job<0>(F, a.in[I_MLAQUP], 384, 1536, 0, WS_WQ, 0, 384, false, r, scr); continue; } r -= N6;
        if (r < N7) { conv_job<3>(F, a.in[I_MLAKVUP], 256, 2048, 0, WS_WK, 0, 256, false, r, scr); continue; } r -= N7;
        if (r < N8) { conv_job<0>(F, a.in[I_MLAWOUT], 1024, 1024, 0, WS_WO, 0, 1024, false, r, scr); continue; } r -= N8;
        conv_job<0>(F, a.in[I_ROUTW], 1024, 64, 1024 * 64, WS_ROUT, 64 * 1024 * 2, 1024, false, r, scr);
    }
    const int gt = F.bid * 512 + F.tid, NGT = F.G * 512;
    for (int i = gt; i < 96 * 128; i += NGT) { *(u32x4*)(F.ws + WS_WIN + (size_t)EVC * 2048 + (size_t)i * 16) = (u32x4){0u, 0u, 0u, 0u}; *(u32x4*)(F.ws + WS_WMLA + (size_t)MLAC * 2048 + (size_t)i * 16) = (u32x4){0u, 0u, 0u, 0u}; }
    float* rope = ws_f32(F, WS_ROPE);
    for (int i = gt; i < SEQ * 16; i += NGT) { const int t = i >> 4, k = i & 15; const float idx = (k < 8) ? (float)(t / 64) : (float)(t % 64); const float fr_ = powf(10000.f, -(float)(k & 7) / 8.f);
        const float ang = idx * fr_; rope[i] = cosf(ang); rope[SEQ * 16 + i] = sinf(ang); }
}


constexpr int DRIP_UNITS = 390 * 512;
struct Drip { float v[8]; float v2[8]; int c; };
__device__ __forceinline__ void drip_addr(const Frame& F, const Args& a, int U, int lane, const float*& src, bf16_t*& dst, int& N) {
    const int mat = U >> 9, u = U & 511, t = mat / 130, idx = mat - t * 130, ly = idx / 65, e = idx - ly * 65;
    const float* base = (e < 64) ? a.in[I_EW1 + t] + (size_t)(ly * 64 + e) * 262144 : a.in[I_SW1 + t] + (size_t)ly * 262144;
    if (t < 2) { const int k8 = u >> 2, n = (u & 3) * 64 + lane; N = 256; src = base + (size_t)(k8 * 8) * 256 + n;
        dst = ws_bf(F, WS_W13) + ((size_t)(ly * 65 + e) * 512 + (n >> 7) * 256 + t * 128 + (n & 127)) * 1024 + k8 * 8; }
    else { const int k8 = u >> 4, n = (u & 15) * 64 + lane; N = 1024; src = base + (size_t)(k8 * 8) * 1024 + n;
        dst = ws_bf(F, WS_W2E) + ((size_t)(ly * 65 + e) * 1024 + n) * 256 + k8 * 8; }
}
__device__ __forceinline__ void drip_issue(const Frame& F, const Args& a, Drip& d, int lane) {
    const int U = (2 * d.c) * (F.G * 8) + F.bid * 8 + F.wave, U2 = U + F.G * 8;
    if (U < DRIP_UNITS) { const float* src; bf16_t* dst; int N; drip_addr(F, a, U, lane, src, dst, N);
#pragma unroll
        for (int j = 0; j < 8; ++j) d.v[j] = src[(size_t)j * N]; }
    if (U2 < DRIP_UNITS) { const float* src; bf16_t* dst; int N; drip_addr(F, a, U2, lane, src, dst, N);
#pragma unroll
        for (int j = 0; j < 8; ++j) d.v2[j] = src[(size_t)j * N]; }
}
__device__ __forceinline__ void drip_store(const Frame& F, const Args& a, Drip& d, int lane) {
    const int U = (2 * d.c) * (F.G * 8) + F.bid * 8 + F.wave, U2 = U + F.G * 8;
    if (U < DRIP_UNITS) { const float* src; bf16_t* dst; int N; drip_addr(F, a, U, lane, src, dst, N);
        u32x4 o; o.x = pk2(d.v[0], d.v[1]); o.y = pk2(d.v[2], d.v[3]); o.z = pk2(d.v[4], d.v[5]); o.w = pk2(d.v[6], d.v[7]); *(u32x4*)dst = o; }
    if (U2 < DRIP_UNITS) { const float* src; bf16_t* dst; int N; drip_addr(F, a, U2, lane, src, dst, N);
        u32x4 o; o.x = pk2(d.v2[0], d.v2[1]); o.y = pk2(d.v2[2], d.v2[3]); o.z = pk2(d.v2[4], d.v2[5]); o.w = pk2(d.v2[6], d.v2[7]); *(u32x4*)dst = o; }
    ++d.c;
}

__device__ __forceinline__ void norm_mod_row(const float* src, const float* gw, const float* shift, const float* scale, bf16_t* dst, int lane) {
    f32x4 v[4]; float ss = 0.f;
#pragma unroll
    for (int j = 0; j < 4; ++j) { v[j] = *(const f32x4*)(src + 4 * lane + 256 * j); ss += v[j][0] * v[j][0] + v[j][1] * v[j][1] + v[j][2] * v[j][2] + v[j][3] * v[j][3]; }
    const float rs = rsqrtf(wave_sum(ss) * (1.f / D) + NORM_EPS);
#pragma unroll
    for (int j = 0; j < 4; ++j) { const int c = 4 * lane + 256 * j; const f32x4 g4 = *(const f32x4*)(gw + c), sh = *(const f32x4*)(shift + c), sc = *(const f32x4*)(scale + c);
        const f32x4 o = (v[j] * rs * g4) * (1.f + sc) + sh;
        u32x2 w; w.x = pk2(o[0], o[1]); w.y = pk2(o[2], o[3]); *(u32x2*)(dst + c) = w; }
}
__device__ __forceinline__ const float* resid_row(const float* lat, const float* ctxp, int g, int& modrow) {
    const int b = g / TPB, p = g - b * TPB;
    if (p < CTXL) { modrow = 32; return ctxp + (size_t)(b * CTXL + p) * D; }
    modrow = b; return lat + (size_t)(b * SEQ + p - CTXL) * D;
}
__device__ __forceinline__ const bf16_t* resid_row_bf(const bf16_t* lat, const bf16_t* ctxp, int g, int& modrow) {
    const int b = g / TPB, p = g - b * TPB;
    if (p < CTXL) { modrow = 32; return ctxp + (size_t)(b * CTXL + p) * D; }
    modrow = b; return lat + (size_t)(b * SEQ + p - CTXL) * D;
}
__device__ __forceinline__ void rows4_bf_load(const bf16_t* const (&src)[4], u32x4 (&raw)[4][2], int lane) {
#pragma unroll
    for (int r = 0; r < 4; ++r)
#pragma unroll
        for (int j = 0; j < 2; ++j) raw[r][j] = *(const u32x4*)(src[r] + 8 * lane + 512 * j);
}
__device__ __forceinline__ void rows4_bf_finish(const u32x4 (&raw)[4][2], const float* gw, const float* const (&mv)[4], bf16_t* const (&dst)[4], int lane) {
    float ss[4];
#pragma unroll
    for (int r = 0; r < 4; ++r) { float s = 0.f;
#pragma unroll
        for (int j = 0; j < 2; ++j) { float v[8]; unpack8(raw[r][j], v);
#pragma unroll
            for (int c = 0; c < 8; ++c) s += v[c] * v[c]; }
        ss[r] = s; }
#pragma unroll
    for (int r = 0; r < 4; ++r) ss[r] = rsqrtf(wave_sum(ss[r]) * (1.f / D) + NORM_EPS);
#pragma unroll
    for (int j = 0; j < 2; ++j) { const int c0 = 8 * lane + 512 * j; const f32x4 g0 = *(const f32x4*)(gw + c0), g1 = *(const f32x4*)(gw + c0 + 4);
#pragma unroll
        for (int r = 0; r < 4; ++r) { float v[8]; unpack8(raw[r][j], v);
            const f32x4 sh0 = *(const f32x4*)(mv[r] + c0), sh1 = *(const f32x4*)(mv[r] + c0 + 4), sc0 = *(const f32x4*)(mv[r] + D + c0), sc1 = *(const f32x4*)(mv[r] + D + c0 + 4);
            const f32x4 o0 = ((f32x4){v[0], v[1], v[2], v[3]} * ss[r] * g0) * (1.f + sc0) + sh0, o1 = ((f32x4){v[4], v[5], v[6], v[7]} * ss[r] * g1) * (1.f + sc1) + sh1;
            u32x4 w; w.x = pk2(o0[0], o0[1]); w.y = pk2(o0[2], o0[3]); w.z = pk2(o1[0], o1[1]); w.w = pk2(o1[2], o1[3]); *(u32x4*)(dst[r] + c0) = w; } }
}
__device__ __forceinline__ void norm_mod_rows4_bf(const bf16_t* const (&src)[4], const float* gw, const float* const (&mv)[4], bf16_t* const (&dst)[4], int lane) {
    u32x4 raw[4][2]; rows4_bf_load(src, raw, lane); rows4_bf_finish(raw, gw, mv, dst, lane);
}
__device__ __forceinline__ void norm_mod_rows4(const float* const (&src)[4], const float* gw, const float* const (&mv)[4], bf16_t* const (&dst)[4], int lane) {
    f32x4 v[4][4]; float ss[4];
#pragma unroll
    for (int r = 0; r < 4; ++r)
#pragma unroll
        for (int j = 0; j < 4; ++j) v[r][j] = *(const f32x4*)(src[r] + 4 * lane + 256 * j);
#pragma unroll
    for (int r = 0; r < 4; ++r) { float s = 0.f;
#pragma unroll
        for (int j = 0; j < 4; ++j) s += v[r][j][0] * v[r][j][0] + v[r][j][1] * v[r][j][1] + v[r][j][2] * v[r][j][2] + v[r][j][3] * v[r][j][3];
        ss[r] = s; }
#pragma unroll
    for (int r = 0; r < 4; ++r) ss[r] = rsqrtf(wave_sum(ss[r]) * (1.f / D) + NORM_EPS);
#pragma unroll
    for (int j = 0; j < 4; ++j) { const int c = 4 * lane + 256 * j; const f32x4 g4 = *(const f32x4*)(gw + c);
#pragma unroll
        for (int r = 0; r < 4; ++r) { const f32x4 sh = *(const f32x4*)(mv[r] + c), sc = *(const f32x4*)(mv[r] + D + c);
            const f32x4 o = (v[r][j] * ss[r] * g4) * (1.f + sc) + sh;
            u32x2 w; w.x = pk2(o[0], o[1]); w.y = pk2(o[2], o[3]); *(u32x2*)(dst[r] + c) = w; } }
}
__device__ __forceinline__ void p_normmod(const Frame& F, const float* lat, const float* ctxp, const float* gw, const float* mods, int chunk, bf16_t* dst) {
    const int gw_ = F.bid * 8 + F.wave, NGW = F.G * 8;
    for (int g = gw_; g < MALL; g += 4 * NGW) { const float* src[4]; const float* mv[4]; bf16_t* dp[4];
#pragma unroll
        for (int r = 0; r < 4; ++r) { int mr; const int gg = g + r * NGW < MALL ? g + r * NGW : g; src[r] = resid_row(lat, ctxp, gg, mr); mv[r] = mods + (size_t)mr * 6144 + chunk * D; dp[r] = dst + (size_t)gg * D; }
        norm_mod_rows4(src, gw, mv, dp, F.lane); }
}

struct L64  { LAS unsigned char* p; __device__ __forceinline__ bf16x8 get(int row, int g) const { return *(const LAS bf16x8*)(p + row * 128 + ((g ^ (row & 7) ^ ((row >> 3) & 7)) << 4)); } };
struct L128 { LAS unsigned char* p; __device__ __forceinline__ bf16x8 get(int row, int g) const { return *(const LAS bf16x8*)(p + row * 256 + ((g ^ (row & 15)) << 4)); } };
struct GM   { const bf16_t* p; int ld; __device__ __forceinline__ bf16x8 get(int row, int g) const { return *(const bf16x8*)(p + (size_t)row * ld + g * 8); } };
__device__ __forceinline__ int sw64(int r, int c) { return r * 128 + ((((c) >> 3) ^ (r & 7) ^ ((r >> 3) & 7)) << 4) + ((c) & 7) * 2; }
__device__ __forceinline__ int sw128(int r, int c) { return r * 256 + ((((c) >> 3) ^ (r & 15)) << 4) + ((c) & 7) * 2; }
template <int KS, class OA, class OB>
__device__ __forceinline__ void mm32(f32x16& acc, const OA& a, int ar0, int ag0, const OB& b, int br0, int bg0, int lane) {
    const int r = lane & 31, h = lane >> 5;
#pragma unroll KS <= 8 ? KS : 4
    for (int s = 0; s < KS; ++s) { const bf16x8 av = a.get(ar0 + r, ag0 + 2 * s + h), bv = b.get(br0 + r, bg0 + 2 * s + h);
        acc = __builtin_amdgcn_mfma_f32_32x32x16_bf16(av, bv, acc, 0, 0, 0); }
}
__device__ __forceinline__ void stT64(const f32x16& acc, LAS unsigned char* X, int n0, int m0, int lane) {
    const int n = n0 + (lane & 31), h = lane >> 5;
#pragma unroll
    for (int g = 0; g < 4; ++g) { u32x2 w; w.x = pk2(acc[4 * g], acc[4 * g + 1]); w.y = pk2(acc[4 * g + 2], acc[4 * g + 3]); *(LAS u32x2*)(X + sw64(n, m0 + 8 * g + 4 * h)) = w; }
}
__device__ __forceinline__ void stT128(const f32x16& acc, LAS unsigned char* X, int n0, int m0, int lane) {
    const int n = n0 + (lane & 31), h = lane >> 5;
#pragma unroll
    for (int g = 0; g < 4; ++g) { u32x2 w; w.x = pk2(acc[4 * g], acc[4 * g + 1]); w.y = pk2(acc[4 * g + 2], acc[4 * g + 3]); *(LAS u32x2*)(X + sw128(n, m0 + 8 * g + 4 * h)) = w; }
}
#define ZERO16 (f32x16){0.f,0.f,0.f,0.f,0.f,0.f,0.f,0.f,0.f,0.f,0.f,0.f,0.f,0.f,0.f,0.f}

constexpr int SLOT = 8192;
enum { S_AT = 0, S_RT, S_KT, S_BT, S_VT, S_KH, S_BH, S_SB, S_MK, S_NK, S_NB, S_L, S_LT, S_XA, S_QA, S_QTA };
constexpr int S_RHS = S_KT, S_XB = S_BT, S_QB = S_AT, S_QTB = S_MK, S_U = S_QA, S_SG = S_L  , S_XW = S_XA, S_XAA = S_QA;
constexpr int WPRE_OFF = S_MK * SLOT;
__device__ __forceinline__ void rwkv_task(const Frame& F, const Args& a, int task) {
    const int b = task >> 3, h = task & 7, lane0 = F.lane, w = F.wave; int lane = lane0, tid = F.tid;
    LAS unsigned char* L = F.lds;
    LAS float* misc = (LAS float*)(F.lds + MISC_OFF);
    const bf16_t* cols = ws_bf(F, WS_COLS);
    bf16_t* mixin = (bf16_t*)F.dout;
    float* bsumg = ws_f32(F, WS_BSUM);
    int hc = h * 64 + lane;
    const float mu_r = a.in[I_RWMU][hc], mu_k = a.in[I_RWMU][512 + hc], mu_v = a.in[I_RWMU][1024 + hc];
    const float kkp = a.in[I_RWKK][hc], kap = a.in[I_RWKA][hc], rkp = a.in[I_RWRK][hc];
#define SL(s) (L + (s) * SLOT)
    if (tid < 64) { misc[640 + tid] = a.in[I_RWGNW][h * 64 + tid]; misc[704 + tid] = a.in[I_RWGNB][h * 64 + tid]; }
    for (int dir = 0; dir < 2; ++dir) {
        const float w0p = a.in[I_RWW0][dir * 512 + hc], a0p = a.in[I_RWA0][dir * 512 + hc];
        const GM w2g{ws_bf(F, WS_W2T) + (size_t)(dir * 512 + h * 64) * 64, 64}, a2g{ws_bf(F, WS_A2T) + (size_t)(dir * 512 + h * 64) * 64, 64};
        if (tid < 64) { misc[768 + tid] = a.in[I_RWMU][(dir ? C_XWB : C_XWF) + tid]; misc[832 + tid] = a.in[I_RWMU][(dir ? C_XAB : C_XAF) + tid]; misc[896 + tid] = a.in[I_RWMU][C_XG + tid]; misc[960 + tid] = a.in[I_RWMU][C_XG + 64 + tid]; }
        bf16x8 wfr[4];
        { const GM& wsrc = (w >> 2) ? a2g : w2g;
#pragma unroll
          for (int s = 0; s < 4; ++s) wfr[s] = wsrc.get(((w >> 1) & 1) * 32 + (lane0 & 31), 2 * s + (lane0 >> 5)); }
        f32x16 sreg = ZERO16;
        for (int i = tid; i < SLOT / 4; i += 512) ((LAS unsigned*)SL(S_SB))[i] = 0u;
        __syncthreads();
        for (int seg = 0; seg < 2; ++seg) {
            const int len = seg ? SEQ : CTXL, g0 = b * TPB + (seg ? CTXL : 0);
            for (int c0 = 0; c0 < len; c0 += 64) {
#define POS(s) (dir ? (len - 1 - (c0 + (s))) : (c0 + (s)))
                lane = opaque(lane0); tid = w * 64 + lane; hc = h * 64 + lane;
                { const int tk = tid >> 3, c8 = (tid & 7) * 8;
                  float cw[3][8], ca[3][8];
#pragma unroll
                  for (int q = 0; q < 3; ++q) { const int s = tk - 1 + q, ps = POS(s); const bool ok = (s >= -c0) && (c0 + s < len);
                      const int pcl = ps < 0 ? 0 : (ps >= len ? len - 1 : ps); const bf16_t* rp = cols + (size_t)(g0 + pcl) * EVP;
                      u32x4 vw = *(const u32x4*)(rp + (dir ? C_XWB : C_XWF) + c8), va = *(const u32x4*)(rp + (dir ? C_XAB : C_XAF) + c8);
                      if (!ok) { vw = (u32x4){0u, 0u, 0u, 0u}; va = vw; }
                      unpack8(vw, cw[q]); unpack8(va, ca[q]); }
                  float ow[8], oa[8];
                  float muw[8], mua[8]; { const f32x4 m0 = *(const LAS f32x4*)(misc + 768 + c8), m1 = *(const LAS f32x4*)(misc + 772 + c8), m2 = *(const LAS f32x4*)(misc + 832 + c8), m3 = *(const LAS f32x4*)(misc + 836 + c8);
#pragma unroll
                      for (int j = 0; j < 4; ++j) { muw[j] = m0[j]; muw[4 + j] = m1[j]; mua[j] = m2[j]; mua[4 + j] = m3[j]; } }
#pragma unroll
                  for (int j = 0; j < 8; ++j) {
                      ow[j] = tanhf_(cw[1][j] + muw[j] * (0.5f * (cw[0][j] + cw[2][j]) - cw[1][j])); oa[j] = ca[1][j] + mua[j] * (0.5f * (ca[0][j] + ca[2][j]) - ca[1][j]); }
                  u32x4 pw, pa; pw.x = pk2(ow[0], ow[1]); pw.y = pk2(ow[2], ow[3]); pw.z = pk2(ow[4], ow[5]); pw.w = pk2(ow[6], ow[7]);
                  pa.x = pk2(oa[0], oa[1]); pa.y = pk2(oa[2], oa[3]); pa.z = pk2(oa[4], oa[5]); pa.w = pk2(oa[6], oa[7]);
                  *(LAS u32x4*)(SL(S_XW) + sw64(tk, c8)) = pw; *(LAS u32x4*)(SL(S_XAA) + sw64(tk, c8)) = pa; }
                LBAR();
                lane = opaque(lane0); tid = w * 64 + lane; hc = h * 64 + lane;
                { const int mat = w >> 2, tm = (w >> 1) & 1, tn = w & 1; f32x16 acc = ZERO16;
                  const L64 xin{SL(mat ? S_XAA : S_XW)};
#pragma unroll
                  for (int s = 0; s < 4; ++s) acc = __builtin_amdgcn_mfma_f32_32x32x16_bf16(wfr[s], xin.get(tn * 32 + (lane & 31), 2 * s + (lane >> 5)), acc, 0, 0, 0);
                  LAS float* wp = (LAS float*)(L + WPRE_OFF) + (mat * 64 + tn * 32 + (lane & 31)) * 68 + tm * 32 + 4 * (lane >> 5);
#pragma unroll
                  for (int g = 0; g < 4; ++g) *(LAS f32x4*)(wp + 8 * g) = (f32x4){acc[4 * g], acc[4 * g + 1], acc[4 * g + 2], acc[4 * g + 3]}; }
                LBAR();
                lane = opaque(lane0); tid = w * 64 + lane; hc = h * 64 + lane;
                { float rr[10], kr[10], vr[10];
#pragma unroll
                  for (int q = 0; q < 10; ++q) { const int s = 8 * w - 1 + q, ps = POS(s); const bool ok = (c0 + s >= 0) && (c0 + s < len);
                      const int pcl = ps < 0 ? 0 : (ps >= len ? len - 1 : ps); const bf16_t* rp = cols + (size_t)(g0 + pcl) * EVP + hc;
                      float x0 = bf2f(rp[C_R]), x1 = bf2f(rp[C_K]), x2 = bf2f(rp[C_V]); if (!ok) { x0 = 0.f; x1 = 0.f; x2 = 0.f; }
                      rr[q] = x0; kr[q] = x1; vr[q] = x2; }
                  float lw[8], kd[8], bb[8], kk[8], rv[8], vv[8], pn[8], pb[8];
                  const int jl = lane >> 4;
                  const float bpA = dir ? __builtin_nontemporal_load(bsumg + (size_t)(g0 + POS(8 * w + jl)) * 8 + h) : 0.f, bpB = dir ? __builtin_nontemporal_load(bsumg + (size_t)(g0 + POS(8 * w + 4 + jl)) * 8 + h) : 0.f;
                  const LAS float* wpw = (const LAS float*)(L + WPRE_OFF), *wpa = wpw + 64 * 68;
#pragma unroll
                  for (int j = 0; j < 8; ++j) { const int i = 8 * w + j;
                      const float r_ = rr[j + 1] + mu_r * (0.5f * (rr[j] + rr[j + 2]) - rr[j + 1]);
                      const float k_ = kr[j + 1] + mu_k * (0.5f * (kr[j] + kr[j + 2]) - kr[j + 1]);
                      const float v_ = vr[j + 1] + mu_v * (0.5f * (vr[j] + vr[j + 2]) - vr[j + 1]);
                      const float kq = k_ * kkp; kk[j] = kq; pn[j] = kq * kq;
                      const float wpre = w0p + wpw[i * 68 + lane], apre = a0p + wpa[i * 68 + lane];
                      const float wlog = -softplusf_(-wpre) - 0.5f; lw[j] = -__expf(wlog);
                      const float av = sigmoidf_(apre);
                      kd[j] = k_ * (1.f + (av - 1.f) * kap); bb[j] = av; rv[j] = r_; vv[j] = v_;
                      pb[j] = r_ * kd[j] * rkp; }
                  { const float n0 = rowsum4(pn[0], pn[1], pn[2], pn[3]), n1 = rowsum4(pn[4], pn[5], pn[6], pn[7]);
                    const float s0 = rowsum4(pb[0], pb[1], pb[2], pb[3]), s1 = rowsum4(pb[4], pb[5], pb[6], pb[7]);
#pragma unroll
                    for (int j = 0; j < 8; ++j) { const float n2 = __int_as_float(__builtin_amdgcn_readlane(__float_as_int(j < 4 ? n0 : n1), 16 * (j & 3)));
                        const float kkn = kk[j] * rsqrtf(n2 + 1e-12f); kk[j] = kkn; bb[j] = kkn * bb[j]; }
                    if ((lane & 15) == 0) { const int iA = 8 * w + jl, iB = iA + 4;
                        if (!dir) { bsumg[(size_t)(g0 + POS(iA)) * 8 + h] = s0; bsumg[(size_t)(g0 + POS(iB)) * 8 + h] = s1; }
                        misc[576 + iA] = s0 + bpA; misc[576 + iB] = s1 + bpB; } }
                  float cl[8]; cl[0] = lw[0];
#pragma unroll
                  for (int j = 1; j < 8; ++j) cl[j] = cl[j - 1] + lw[j];
                  misc[64 + w * 64 + lane] = cl[7];
                  LBAR();
                  float off = 0.f, tot = 0.f;
#pragma unroll
                  for (int o = 0; o < 8; ++o) { const float t = misc[64 + o * 64 + lane]; tot += t; if (o < w) off += t; }
                  if (w == 0) misc[lane] = __expf(tot);
                  float oKH[8], oBH[8];
#pragma unroll
                  for (int j = 0; j < 8; ++j) { const int i = 8 * w + j; const float cum = off + cl[j]; const float Pi = __expf(cum), Pm1 = __expf(cum - lw[j]), iP = __expf(-cum), PCr = __expf(tot - cum);
                      *(LAS bf16_t*)(SL(S_AT) + sw64(i, lane)) = f2bf(kk[j] * Pm1); *(LAS bf16_t*)(SL(S_RT) + sw64(i, lane)) = f2bf(rv[j] * Pi);
                      *(LAS bf16_t*)(SL(S_KT) + sw64(i, lane)) = f2bf(kd[j] * iP); *(LAS bf16_t*)(SL(S_BT) + sw64(i, lane)) = f2bf(bb[j] * iP);
                      oKH[j] = kd[j] * PCr; oBH[j] = -bb[j] * PCr; }
                  u32x4 t;
                  t.x = pk2(oKH[0], oKH[1]); t.y = pk2(oKH[2], oKH[3]); t.z = pk2(oKH[4], oKH[5]); t.w = pk2(oKH[6], oKH[7]); *(LAS u32x4*)(SL(S_KH) + sw64(lane, 8 * w)) = t;
                  t.x = pk2(oBH[0], oBH[1]); t.y = pk2(oBH[2], oBH[3]); t.z = pk2(oBH[4], oBH[5]); t.w = pk2(oBH[6], oBH[7]); *(LAS u32x4*)(SL(S_BH) + sw64(lane, 8 * w)) = t;
                  t.x = pk2(vv[0], vv[1]); t.y = pk2(vv[2], vv[3]); t.z = pk2(vv[4], vv[5]); t.w = pk2(vv[6], vv[7]); *(LAS u32x4*)(SL(S_VT) + sw64(lane, 8 * w)) = t; }
                LBAR();
                lane = opaque(lane0); tid = w * 64 + lane; hc = h * 64 + lane;
                f32x16 xf = ZERO16;
                unsigned pf = 0u;
                if (c0 + 64 < len && (dir || w < 5)) { const int sn = c0 + 64 + (w == 7 ? lane : ((c0 + 65 + lane < len) ? 1 + lane : 0)), pn = dir ? (len - 1 - sn) : sn;
                    const int coff = w == 0 ? (dir ? C_XWB : C_XWF) : w == 1 ? (dir ? C_XAB : C_XAF) : w == 2 ? C_R + h * 64 : w == 3 ? C_K + h * 64 : w == 4 ? C_V + h * 64 : w == 5 ? C_XG : C_XG + 64;
                    const bf16_t* pp = (w == 7) ? mixin + (size_t)(g0 + pn) * MIXD + h * 64 : cols + (size_t)(g0 + pn) * EVP + coff;
                    pf = *(const unsigned*)pp; }
                const int ti = (w >> 1) & 1, tj = w & 1;
                { const L64 AT{SL(S_AT)}, RT{SL(S_RT)}, KT{SL(S_KT)}, BT{SL(S_BT)};
                  const int i = ti * 32 + (lane & 31), hh = lane >> 5;
                  if (w < 4) {
                      f32x16 l_ = ZERO16, nk = ZERO16;
                      if (tj <= ti) { mm32<4>(l_, BT, tj * 32, 0, AT, ti * 32, 0, lane); mm32<4>(nk, KT, tj * 32, 0, RT, ti * 32, 0, lane); }
#pragma unroll
                      for (int r = 0; r < 16; ++r) { const int j = tj * 32 + crow(r, hh); l_[r] = (j < i) ? l_[r] : 0.f; nk[r] = (j <= i) ? nk[r] : 0.f; xf[r] = ((j == i) ? 1.f : 0.f) - l_[r]; }
                      stT64(l_, SL(S_L), ti * 32, tj * 32, lane); stT64(nk, SL(S_NK), ti * 32, tj * 32, lane); stT64(xf, SL(S_XA), ti * 32, tj * 32, lane);
                  } else {
                      f32x16 mk = ZERO16, nb = ZERO16, lt = ZERO16;
                      if (tj <= ti) { mm32<4>(mk, KT, tj * 32, 0, AT, ti * 32, 0, lane); mm32<4>(nb, BT, tj * 32, 0, RT, ti * 32, 0, lane); }
#pragma unroll
                      for (int r = 0; r < 16; ++r) { const int j = tj * 32 + crow(r, hh); mk[r] = (j < i) ? mk[r] : 0.f; nb[r] = (j <= i) ? -nb[r] : 0.f; }
                      stT64(mk, SL(S_MK), ti * 32, tj * 32, lane); stT64(nb, SL(S_NB), ti * 32, tj * 32, lane);
                      const int jl = ti * 32 + (lane & 31);
                      if (ti <= tj) mm32<4>(lt, AT, tj * 32, 0, BT, ti * 32, 0, lane);
#pragma unroll
                      for (int r = 0; r < 16; ++r) { const int ii = tj * 32 + crow(r, hh); lt[r] = (jl < ii) ? lt[r] : 0.f; }
                      stT64(lt, SL(S_LT), ti * 32, tj * 32, lane);
                  } }
                LBAR();
                lane = opaque(lane0); tid = w * 64 + lane; hc = h * 64 + lane;
                { const L64 Lm{SL(S_L)}, LTm{SL(S_LT)};
                  if (w < 4) { f32x16 q = ZERO16, qt = ZERO16;
                      mm32<4>(q, LTm, tj * 32, 0, Lm, ti * 32, 0, lane);   stT64(q, SL(S_QA), ti * 32, tj * 32, lane);
                      mm32<4>(qt, Lm, tj * 32, 0, LTm, ti * 32, 0, lane);  stT64(qt, SL(S_QTA), ti * 32, tj * 32, lane);
                  } else { f32x16 rh = ZERO16; const L64 AT{SL(S_AT)}, SB{SL(S_SB)}, MK{SL(S_MK)}, VT{SL(S_VT)};
                      mm32<4>(rh, AT, tj * 32, 0, SB, ti * 32, 0, lane); mm32<4>(rh, MK, tj * 32, 0, VT, ti * 32, 0, lane);
                      stT64(rh, SL(S_RHS), ti * 32, tj * 32, lane); } }
                LBAR();
                lane = opaque(lane0); tid = w * 64 + lane; hc = h * 64 + lane;
#pragma unroll
                for (int it = 0; it < 4; ++it) { const bool fromA = (it & 1) == 0; lane = opaque(lane0);
                    const L64 Xs{SL(fromA ? S_XA : S_XB)}, Qs{SL(fromA ? S_QA : S_QB)}, QTs{SL(fromA ? S_QTA : S_QTB)};
                    LAS unsigned char* Xd = SL(fromA ? S_XB : S_XA); LAS unsigned char* Qd = SL(fromA ? S_QB : S_QA); LAS unsigned char* QTd = SL(fromA ? S_QTB : S_QTA);
                    if (w < 4) { mm32<4>(xf, QTs, tj * 32, 0, Xs, ti * 32, 0, lane); stT64(xf, Xd, ti * 32, tj * 32, lane); }
                    else { f32x16 q = ZERO16, qt = ZERO16;
                        mm32<4>(q, QTs, tj * 32, 0, Qs, ti * 32, 0, lane); stT64(q, Qd, ti * 32, tj * 32, lane);
                        mm32<4>(qt, Qs, tj * 32, 0, QTs, ti * 32, 0, lane); stT64(qt, QTd, ti * 32, tj * 32, lane); }
                    LBAR(); }
                lane = opaque(lane0); tid = w * 64 + lane; hc = h * 64 + lane;
                if (w < 4) { const L64 Xs{SL(S_XA)}, QTs{SL(S_QTA)}; mm32<4>(xf, QTs, tj * 32, 0, Xs, ti * 32, 0, lane); stT64(xf, SL(S_XB), ti * 32, tj * 32, lane); }
                else if (dir) {
#pragma unroll
                    for (int it = 0; it < 4; ++it) { const int item = (tid - 256) + it * 256, tk = item >> 4, c8 = (item & 15) * 8;
                        float cg[3][8];
#pragma unroll
                        for (int q = 0; q < 3; ++q) { const int s = tk - 1 + q, ps = POS(s); const bool ok = (c0 + s >= 0) && (c0 + s < len); const int pcl = ps < 0 ? 0 : (ps >= len ? len - 1 : ps);
                            u32x4 vg = *(const u32x4*)(cols + (size_t)(g0 + pcl) * EVP + C_XG + c8); if (!ok) vg = (u32x4){0u, 0u, 0u, 0u}; unpack8(vg, cg[q]); }
                        float og[8];
                        const f32x4 mg0 = *(const LAS f32x4*)(misc + 896 + c8), mg1 = *(const LAS f32x4*)(misc + 900 + c8);
#pragma unroll
                        for (int j = 0; j < 8; ++j) { const float mug = j < 4 ? mg0[j & 3] : mg1[j & 3]; og[j] = sigmoidf_(cg[1][j] + mug * (0.5f * (cg[0][j] + cg[2][j]) - cg[1][j])); }
                        u32x4 pg; pg.x = pk2(og[0], og[1]); pg.y = pk2(og[2], og[3]); pg.z = pk2(og[4], og[5]); pg.w = pk2(og[6], og[7]);
                        *(LAS u32x4*)(SL(S_SG) + sw128(tk, c8)) = pg; } }
                LBAR();
                lane = opaque(lane0); tid = w * 64 + lane; hc = h * 64 + lane;
                if (w < 4) { f32x16 u = ZERO16; const L64 Z{SL(S_XB)}, RH{SL(S_RHS)};
                    mm32<4>(u, Z, tj * 32, 0, RH, ti * 32, 0, lane);
                    stT64(u, SL(S_U), ti * 32, tj * 32, lane); }
                LBAR();
                lane = opaque(lane0); tid = w * 64 + lane; hc = h * 64 + lane;
                { const L64 SB{SL(S_SB)}, VT{SL(S_VT)}, U{SL(S_U)}, RT{SL(S_RT)}, NK{SL(S_NK)}, NB{SL(S_NB)}, KH{SL(S_KH)}, BH{SL(S_BH)};
                  if (w < 2) {
                      f32x16 y0 = ZERO16, y1 = ZERO16;
                      mm32<4>(y0, SB, 0, 0, RT, w * 32, 0, lane);  mm32<4>(y0, VT, 0, 0, NK, w * 32, 0, lane);  mm32<4>(y0, U, 0, 0, NB, w * 32, 0, lane);
                      mm32<4>(y1, SB, 32, 0, RT, w * 32, 0, lane); mm32<4>(y1, VT, 32, 0, NK, w * 32, 0, lane); mm32<4>(y1, U, 32, 0, NB, w * 32, 0, lane);
                      const int i = w * 32 + (lane & 31), hh = lane >> 5; const size_t grow = (size_t)(g0 + POS(i));
                      bf16_t* op = mixin + grow * MIXD + h * 64;
                      if (!dir) {
#pragma unroll
                          for (int g = 0; g < 4; ++g) { u32x2 o0, o1; o0.x = pk2(y0[4 * g], y0[4 * g + 1]); o0.y = pk2(y0[4 * g + 2], y0[4 * g + 3]); o1.x = pk2(y1[4 * g], y1[4 * g + 1]); o1.y = pk2(y1[4 * g + 2], y1[4 * g + 3]);
                              *(u32x2*)(op + 8 * g + 4 * hh) = o0; *(u32x2*)(op + 32 + 8 * g + 4 * hh) = o1; }
                      } else {
                          f32x16 g0a = ZERO16, g1a = ZERO16; const GM g2g{ws_bf(F, WS_G2T) + (size_t)(h * 64) * 128, 128}; const L128 SG{SL(S_SG)};
                          mm32<8>(g0a, g2g, 0, 0, SG, w * 32, 0, lane); mm32<8>(g1a, g2g, 32, 0, SG, w * 32, 0, lane);
                          float s1 = 0.f;
#pragma unroll
                          for (int g = 0; g < 4; ++g) { const u32x2 f0 = *(const u32x2*)(op + 8 * g + 4 * hh), f1 = *(const u32x2*)(op + 32 + 8 * g + 4 * hh);
                              y0[4 * g] += bflo(f0.x); y0[4 * g + 1] += bfhi(f0.x); y0[4 * g + 2] += bflo(f0.y); y0[4 * g + 3] += bfhi(f0.y);
                              y1[4 * g] += bflo(f1.x); y1[4 * g + 1] += bfhi(f1.x); y1[4 * g + 2] += bflo(f1.y); y1[4 * g + 3] += bfhi(f1.y); }
#pragma unroll
                          for (int r = 0; r < 16; ++r) s1 += y0[r] + y1[r];
                          s1 += __shfl_xor(s1, 32); const float mean = s1 * (1.f / 64.f); float s2 = 0.f;
#pragma unroll
                          for (int r = 0; r < 16; ++r) { const float d0 = y0[r] - mean, d1 = y1[r] - mean; s2 += d0 * d0 + d1 * d1; }
                          s2 += __shfl_xor(s2, 32); const float rstd = rsqrtf(s2 * (1.f / 64.f) + 64e-5f);
                          const float bsv = misc[576 + i];
#pragma unroll
                          for (int g = 0; g < 4; ++g) { float o0[4], o1[4];
                              const f32x4 gw0 = *(const LAS f32x4*)(misc + 640 + 8 * g + 4 * hh), gb0 = *(const LAS f32x4*)(misc + 704 + 8 * g + 4 * hh), gw1 = *(const LAS f32x4*)(misc + 672 + 8 * g + 4 * hh), gb1 = *(const LAS f32x4*)(misc + 736 + 8 * g + 4 * hh);
#pragma unroll
                              for (int e = 0; e < 4; ++e) { const int ch = 8 * g + 4 * hh + e;
                                  const float v0 = bf2f(*(const LAS bf16_t*)(SL(S_VT) + sw64(ch, i))), v1 = bf2f(*(const LAS bf16_t*)(SL(S_VT) + sw64(32 + ch, i)));
                                  o0[e] = ((y0[4 * g + e] - mean) * rstd * gw0[e] + gb0[e] + bsv * v0) * g0a[4 * g + e];
                                  o1[e] = ((y1[4 * g + e] - mean) * rstd * gw1[e] + gb1[e] + bsv * v1) * g1a[4 * g + e]; }
                              u32x2 p0, p1; p0.x = pk2(o0[0], o0[1]); p0.y = pk2(o0[2], o0[3]); p1.x = pk2(o1[0], o1[1]); p1.y = pk2(o1[2], o1[3]);
                              *(u32x2*)(op + 8 * g + 4 * hh) = p0; *(u32x2*)(op + 32 + 8 * g + 4 * hh) = p1; }
                      }
                  } else if (w >= 4) {
                      f32x16 acc = ZERO16;
                      mm32<4>(acc, KH, tj * 32, 0, VT, ti * 32, 0, lane); mm32<4>(acc, BH, tj * 32, 0, U, ti * 32, 0, lane);
                      const int hh = lane >> 5;
#pragma unroll
                      for (int r = 0; r < 16; ++r) sreg[r] = sreg[r] * misc[tj * 32 + crow(r, hh)] + acc[r];
                  } }
                LBAR();
                lane = opaque(lane0);
                if (w >= 4) stT64(sreg, SL(S_SB), ti * 32, tj * 32, lane);
                asm volatile("" :: "v"(pf));
#undef POS
            }
        }
        __syncthreads();
    }
#undef SL
}

__device__ __forceinline__ void ssd_task(const Frame& F, const Args& a, int task, Drip& drip) {
    const int b = task >> 3, grp = (task >> 2) & 1, qd = task & 3, lane0 = F.lane, w = F.wave, hh = w >> 2, sub = w & 3; int lane = lane0, tid = F.tid;
    const int head0 = grp * 8 + qd * 2, head = head0 + hh;
    LAS unsigned char* L = F.lds;
    LAS float* misc = (LAS float*)(F.lds + MISC_OFF);
    LAS unsigned char* BMs = L, *CMs = L + 16384, *BMTs = L + 32768;
    LAS unsigned char* XTs = L + 49152 + hh * 40960, *XDs = XTs + 8192, *Ms = XTs + 16384, *SBFs = XTs + 24576;
    const bf16_t* cols = ws_bf(F, WS_COLS);
    bf16_t* mixin = (bf16_t*)F.dout;
    const float* cw = a.in[I_CONVW]; const float* cb = a.in[I_CONVB];
    const int t0 = F.tid, g48 = t0 % 48, oc = t0 / 48;
    const int ch0 = (g48 < 16) ? (1024 + grp * 128 + g48 * 8) : (g48 < 32 ? (1280 + grp * 128 + (g48 - 16) * 8) : (head0 * 64 + (g48 - 32) * 8));
    const int dth = w - 6;
    for (int dir = 0; dir < 2; ++dir) {
        const float aneg = -__expf(a.in[I_ALOG][dir * 16 + head]), dsk = a.in[I_SSMD][head];
        const float dtb6 = (w >= 6) ? a.in[I_DTB][dir * 16 + head0 + dth] : 0.f, an6 = (w >= 6) ? -__expf(a.in[I_ALOG][dir * 16 + head0 + dth]) : 0.f;
        if (t0 < 384) {
#pragma unroll 1
            for (int tp = 0; tp < 5; ++tp) { *(LAS f32x4*)(misc + 512 + tp * 384 + g48 * 8) = *(const f32x4*)(cw + (dir ? 4 - tp : tp) * 1536 + ch0); *(LAS f32x4*)(misc + 512 + tp * 384 + g48 * 8 + 4) = *(const f32x4*)(cw + (dir ? 4 - tp : tp) * 1536 + ch0 + 4); }
            if (oc == 0) { *(LAS f32x4*)(misc + 2432 + g48 * 8) = *(const f32x4*)(cb + ch0); *(LAS f32x4*)(misc + 2432 + g48 * 8 + 4) = *(const f32x4*)(cb + ch0 + 4); }
        }
        f32x16 st0 = ZERO16, st1 = ZERO16;
        for (int i = tid; i < 4096; i += 512) { ((LAS unsigned*)(L + 49152 + 24576))[i] = 0u; ((LAS unsigned*)(L + 49152 + 40960 + 24576))[i] = 0u; }
        __syncthreads();
        __builtin_amdgcn_sched_barrier(0);
        u32x4 raw[12]; bf16_t dtraw_u = 0; unsigned okm = 0u;
#define CH_LEN(ci) ((ci) < 4 ? CTXL : SEQ)
#define CH_G0(ci) (b * TPB + ((ci) < 4 ? 0 : CTXL))
#define CH_C0(ci) (((ci) < 4 ? (ci) : (ci) - 4) * 64)
#define SSD_PREFETCH(ci) do { const int len_ = CH_LEN(ci), g0_ = CH_G0(ci), c0_ = CH_C0(ci); \
            if (t0 < 384) { const int s0_ = c0_ + 8 * oc - 2; okm = (s0_ < 0 ? 1u : 0u) | (s0_ + 11 >= len_ ? 2u : 0u);        \
                const bf16_t* p_ = cols + (size_t)(g0_ + (dir ? (len_ - 1 - s0_) : s0_)) * EVP + C_XBC + ch0; const long st_ = dir ? -(long)EVP : (long)EVP; \
                _Pragma("unroll") for (int q = 0; q < 12; ++q) raw[q] = *(const u32x4*)(p_ + q * st_); } \
            else if (w >= 6) { const int ps_ = dir ? (len_ - 1 - (c0_ + lane0)) : (c0_ + lane0); dtraw_u = cols[(size_t)(g0_ + ps_) * EVP + C_DT + dir * 16 + head0 + dth]; } } while (0)
        SSD_PREFETCH(0);
        for (int ci = 0; ci < 36; ++ci) {
            const int len = CH_LEN(ci), g0 = CH_G0(ci), c0 = CH_C0(ci);
#define POS(s) (dir ? (len - 1 - (c0 + (s))) : (c0 + (s)))
                lane = opaque(lane0); tid = w * 64 + lane;
                if (t0 < 384) {
                    const int g48o = opaque(g48), oo = opaque(oc);
                    if (okm & 1u) { raw[0] = (u32x4){0u, 0u, 0u, 0u}; raw[1] = raw[0]; }
                    if (okm & 2u) { raw[10] = (u32x4){0u, 0u, 0u, 0u}; raw[11] = raw[10]; }
                    const bool isB = g48o < 16, isC = (g48o >= 16) && (g48o < 32); const int n0 = (g48o & 15) * 8;
                    LAS unsigned char* dstm = isB ? BMs : CMs;
#pragma unroll
                    for (int hf = 0; hf < 2; ++hf) {
                        f32x4 wq[5];
#pragma unroll
                        for (int tp = 0; tp < 5; ++tp) wq[tp] = *(const LAS f32x4*)(misc + 512 + tp * 384 + g48o * 8 + 4 * hf);
                        const f32x4 bq = *(const LAS f32x4*)(misc + 2432 + g48o * 8 + 4 * hf);
                        float ac[8][4];
#pragma unroll
                        for (int j = 0; j < 8; ++j)
#pragma unroll
                            for (int c = 0; c < 4; ++c) ac[j][c] = bq[c];
#pragma unroll
                        for (int q = 0; q < 12; ++q) { const unsigned wd0 = raw[q][2 * hf], wd1 = raw[q][2 * hf + 1]; const float uv[4] = {bflo(wd0), bfhi(wd0), bflo(wd1), bfhi(wd1)};
#pragma unroll
                            for (int j = 0; j < 8; ++j) { if (q - j >= 0 && q - j < 5) {
#pragma unroll
                                    for (int c = 0; c < 4; ++c) ac[j][c] += wq[q - j][c] * uv[c]; } } }
#pragma unroll
                        for (int j = 0; j < 8; ++j)
#pragma unroll
                            for (int c = 0; c < 4; ++c) ac[j][c] = siluf_(ac[j][c]);
                        if (isB || isC) {
#pragma unroll
                            for (int j = 0; j < 8; ++j) { u32x2 pa; pa.x = pk2(ac[j][0], ac[j][1]); pa.y = pk2(ac[j][2], ac[j][3]); *(LAS u32x2*)(dstm + sw128(8 * oo + j, n0 + 4 * hf)) = pa; } }
                        if (isB || !isC) { LAS unsigned char* tb; int trow;
                            if (isB) { tb = BMTs; trow = n0 + 4 * hf; } else { const int pc = (g48o - 32) * 8; tb = L + 49152 + (pc >> 6) * 40960; trow = (pc & 63) + 4 * hf; }
#pragma unroll
                            for (int c = 0; c < 4; ++c) { u32x4 t4; t4.x = pk2(ac[0][c], ac[1][c]); t4.y = pk2(ac[2][c], ac[3][c]); t4.z = pk2(ac[4][c], ac[5][c]); t4.w = pk2(ac[6][c], ac[7][c]); *(LAS u32x4*)(tb + sw64(trow + c, 8 * oo)) = t4; } }
                        __builtin_amdgcn_sched_barrier(0);
                    }
                } else if (w >= 6) {
                    const float dt = softplusf_(bf2f(dtraw_u) + dtb6); float cs = dt * an6;
#pragma unroll
                    for (int o = 1; o < 64; o <<= 1) { const float t = __shfl_up(cs, o); if (lane >= o) cs += t; }
                    misc[dth * 64 + lane] = cs; misc[128 + dth * 64 + lane] = dt; }
                if (ci + 1 < 36) SSD_PREFETCH(ci + 1);
                LBAR();
                lane = opaque(lane0); tid = w * 64 + lane;
#pragma unroll
                for (int it = 0; it < 2; ++it) { const int item = tid + it * 512, hx = item >> 9, p = (item >> 3) & 63, o8i = item & 7;
                    LAS unsigned char* xt = L + 49152 + hx * 40960; float xv[8]; unpack8(*(const LAS u32x4*)(xt + sw64(p, 8 * o8i)), xv);
                    const float ce = misc[hx * 64 + 63]; float f[8];
#pragma unroll
                    for (int j = 0; j < 8; ++j) f[j] = xv[j] * misc[128 + hx * 64 + 8 * o8i + j] * __expf(ce - misc[hx * 64 + 8 * o8i + j]);
                    u32x4 pw; pw.x = pk2(f[0], f[1]); pw.y = pk2(f[2], f[3]); pw.z = pk2(f[4], f[5]); pw.w = pk2(f[6], f[7]); *(LAS u32x4*)(xt + 8192 + sw64(p, 8 * o8i)) = pw; }
                lane = opaque(lane0); tid = w * 64 + lane;
                const int tl = sub & 1, tp2 = sub >> 1;
                drip_issue(F, a, drip, lane);
                unsigned pf = 0u;
                if (dir && ci + 1 < 36 && w < 4) { const int lenn = CH_LEN(ci + 1), pn = lenn - 1 - (CH_C0(ci + 1) + lane); const size_t gr = (size_t)(CH_G0(ci + 1) + pn);
                    const bf16_t* pp = (w < 2) ? mixin + gr * MIXD + 512 + (head0 + w) * 64 : cols + gr * EVP + C_Z + (head0 + w - 2) * 64;
                    pf = *(const unsigned*)pp; }
                f32x16 yacc = ZERO16;
                { const L128 BMm{BMs}, CMm{CMs}, SBm{SBFs};
                  const int l = tl * 32 + (lane & 31), h5 = lane >> 5; const float csl = misc[hh * 64 + l];
                  f32x16 m = ZERO16;
                  if (tp2 <= tl) mm32<8>(m, BMm, tp2 * 32, 0, CMm, tl * 32, 0, lane);
#pragma unroll
                  for (int r = 0; r < 16; ++r) { const int s = tp2 * 32 + crow(r, h5); m[r] = (s <= l) ? m[r] * __expf(csl - misc[hh * 64 + s]) * misc[128 + hh * 64 + s] : 0.f; }
                  stT64(m, Ms, tl * 32, tp2 * 32, lane);
                  mm32<8>(yacc, SBm, tp2 * 32, 0, CMm, tl * 32, 0, lane);
                  const float el = __expf(csl);
#pragma unroll
                  for (int r = 0; r < 16; ++r) yacc[r] *= el; }
                LBAR();
                lane = opaque(lane0); tid = w * 64 + lane;
                { const L64 XTm{XTs}, XDm{XDs}, Mm{Ms}, BMTm{BMTs};
                  mm32<4>(yacc, XTm, tp2 * 32, 0, Mm, tl * 32, 0, lane);
                  const int l = tl * 32 + (lane & 31), h5 = lane >> 5; const size_t grow = (size_t)(g0 + POS(l));
                  bf16_t* op = mixin + grow * MIXD + 512 + head * 64 + tp2 * 32;
                  if (!dir) {
#pragma unroll
                      for (int g = 0; g < 4; ++g) { u32x2 o; o.x = pk2(yacc[4 * g], yacc[4 * g + 1]); o.y = pk2(yacc[4 * g + 2], yacc[4 * g + 3]); *(u32x2*)(op + 8 * g + 4 * h5) = o; }
                  } else {
                      const bf16_t* zp = cols + grow * EVP + C_Z + head * 64 + tp2 * 32;
#pragma unroll
                      for (int g = 0; g < 4; ++g) { const u32x2 f = *(const u32x2*)(op + 8 * g + 4 * h5), zz = *(const u32x2*)(zp + 8 * g + 4 * h5);
                          const float yf[4] = {bflo(f.x), bfhi(f.x), bflo(f.y), bfhi(f.y)}, zv[4] = {bflo(zz.x), bfhi(zz.x), bflo(zz.y), bfhi(zz.y)}; float o4[4];
#pragma unroll
                          for (int e = 0; e < 4; ++e) { const int pch = tp2 * 32 + 8 * g + 4 * h5 + e; const float xv = bf2f(*(const LAS bf16_t*)(XTs + sw64(pch, l)));
                              o4[e] = (yacc[4 * g + e] + yf[e] + dsk * xv) * siluf_(zv[e]); }
                          u32x2 o; o.x = pk2(o4[0], o4[1]); o.y = pk2(o4[2], o4[3]); *(u32x2*)(op + 8 * g + 4 * h5) = o; }
                  }
                  const int tpp = sub & 1, tn0 = (sub >> 1) * 2; const float dE = __expf(misc[hh * 64 + 63]);
                  f32x16 a0 = ZERO16, a1 = ZERO16;
                  mm32<4>(a0, BMTm, tn0 * 32, 0, XDm, tpp * 32, 0, lane); mm32<4>(a1, BMTm, (tn0 + 1) * 32, 0, XDm, tpp * 32, 0, lane);
#pragma unroll
                  for (int r = 0; r < 16; ++r) { st0[r] = st0[r] * dE + a0[r]; st1[r] = st1[r] * dE + a1[r]; } }
                LBAR();
                lane = opaque(lane0);
                { const int tpp = sub & 1, tn0 = (sub >> 1) * 2; stT128(st0, SBFs, tpp * 32, tn0 * 32, lane); stT128(st1, SBFs, tpp * 32, (tn0 + 1) * 32, lane); }
                asm volatile("" :: "v"(pf));
                drip_store(F, a, drip, lane);
#undef POS
        }
        __syncthreads();
#undef SSD_PREFETCH
#undef CH_LEN
#undef CH_G0
#undef CH_C0
    }
}
__device__ __forceinline__ void p_ssm_norm(const Frame& F, const Args& a) {
    bf16_t* mixin = (bf16_t*)F.dout; const float* nw = a.in[I_SSMNW];
    const int gw = F.bid * 8 + F.wave, NGW = F.G * 8;
    for (int g = gw; g < MALL; g += NGW) { bf16_t* rp = mixin + (size_t)g * MIXD + 512 + F.lane * 16;
        float v[16]; { float t0[8], t1[8]; unpack8(*(const u32x4*)rp, t0); unpack8(*(const u32x4*)(rp + 8), t1);
#pragma unroll
            for (int j = 0; j < 8; ++j) { v[j] = t0[j]; v[8 + j] = t1[j]; } }
        float ss = 0.f;
#pragma unroll
        for (int j = 0; j < 16; ++j) ss += v[j] * v[j];
#pragma unroll
        for (int o = 1; o < 32; o <<= 1) ss += __shfl_xor(ss, o);
        const float rs = rsqrtf(ss * (1.f / 512.f) + NORM_EPS);
        u32x4 o0, o1; const float* wv = nw + F.lane * 16;
        o0.x = pk2(v[0] * rs * wv[0], v[1] * rs * wv[1]); o0.y = pk2(v[2] * rs * wv[2], v[3] * rs * wv[3]); o0.z = pk2(v[4] * rs * wv[4], v[5] * rs * wv[5]); o0.w = pk2(v[6] * rs * wv[6], v[7] * rs * wv[7]);
        o1.x = pk2(v[8] * rs * wv[8], v[9] * rs * wv[9]); o1.y = pk2(v[10] * rs * wv[10], v[11] * rs * wv[11]); o1.z = pk2(v[12] * rs * wv[12], v[13] * rs * wv[13]); o1.w = pk2(v[14] * rs * wv[14], v[15] * rs * wv[15]);
        *(u32x4*)rp = o0; *(u32x4*)(rp + 8) = o1; }
}

template <int TW> __device__ __forceinline__ void p_moe_prep_t(const Frame& F, const Args& a, int ly, const float* mods) {
    LAS float* lg = (LAS float*)(F.lds + F.wave * 9728);
    LAS int* mi = (LAS int*)(F.lds + MISC_OFF);
    const bf16_t* xl = ws_bf(F, WS_XL); const bf16_t* xc = ws_bf(F, WS_XC);
    bf16_t* tok = ws_bf(F, WS_TOK);
    unsigned* cnt = (unsigned*)(F.ws + WS_CTL) + CW_CNT + ly * 64 * 32;
    int* list = (int*)(F.ws + WS_LIST); int* tsel = (int*)(F.ws + WS_TSEL); float* tgate = ws_f32(F, WS_TGATE);
    const float* gw = a.in[I_NFFN] + ly * D; const float* rbias = a.in[I_ROUTB] + ly * 64;
    const GM rt{ws_bf(F, WS_ROUT) + (size_t)ly * 64 * 1024, 1024};
    const int lane = F.lane, w = F.wave;
    { int* idl = list + (size_t)(64 + ly) * CAP; const int gt = F.bid * 512 + F.tid, NGT = F.G * 512;
      if (ly == 0) { for (int i = gt; i < MALL; i += NGT) idl[i] = i; } else { for (int i = gt; i < MLAT; i += NGT) idl[i] = (i >> 11) * TPB + CTXL + (i & (SEQ - 1)); } }
    const int ntile = (TW == 36) ? MALL / 288 : (ly ? MLAT / 256 : MALL / 256);
    for (int tq = F.bid; tq < ntile; tq += F.G) { const int tile = ly ? (tq >> 3) * 9 + 1 + (tq & 7) : tq;
        const int gbase = tile * (8 * TW) + w * TW;
        { u32x4 raw[4][2];
          { const bf16_t* src[4];
#pragma unroll
            for (int r = 0; r < 4; ++r) { int mr; src[r] = resid_row_bf(xl, xc, gbase + r, mr); }
            rows4_bf_load(src, raw, lane); }
          for (int r0 = 0; r0 < TW; r0 += 4) { const float* mv[4]; bf16_t* dp[4]; u32x4 nx[4][2];
#pragma unroll
            for (int r = 0; r < 4; ++r) { int mr; const int g = gbase + r0 + r; (void)resid_row_bf(xl, xc, g, mr); mv[r] = mods + (size_t)mr * 6144 + 3 * D; dp[r] = tok + (size_t)g * D; }
            { const bf16_t* src[4]; const int rn = (r0 + 4 < TW) ? r0 + 4 : r0;
#pragma unroll
              for (int r = 0; r < 4; ++r) { int mr; src[r] = resid_row_bf(xl, xc, gbase + rn + r, mr); }
              rows4_bf_load(src, nx, lane); }
            rows4_bf_finish(raw, gw, mv, dp, lane);
#pragma unroll
            for (int r = 0; r < 4; ++r) { raw[r][0] = nx[r][0]; raw[r][1] = nx[r][1]; } } }
        if (F.tid < 64) mi[F.tid] = 0;
        asm volatile("s_waitcnt vmcnt(0)" ::: "memory");
        __syncthreads();
        f32x16 l0 = ZERO16, l1 = ZERO16, l2 = ZERO16, l3 = ZERO16; const GM tk{tok + (size_t)gbase * D, D};
        { const int r_ = lane & 31, h_ = lane >> 5, r2_ = (TW == 36) ? 32 + (r_ & 3) : 0;
#pragma unroll 4
          for (int s = 0; s < 64; ++s) { const bf16x8 bv = tk.get(r_, 2 * s + h_), a0 = rt.get(r_, 2 * s + h_), a1 = rt.get(32 + r_, 2 * s + h_);
              l0 = __builtin_amdgcn_mfma_f32_32x32x16_bf16(a0, bv, l0, 0, 0, 0); l1 = __builtin_amdgcn_mfma_f32_32x32x16_bf16(a1, bv, l1, 0, 0, 0);
              if (TW == 36) { const bf16x8 bw = tk.get(r2_, 2 * s + h_); l2 = __builtin_amdgcn_mfma_f32_32x32x16_bf16(a0, bw, l2, 0, 0, 0); l3 = __builtin_amdgcn_mfma_f32_32x32x16_bf16(a1, bw, l3, 0, 0, 0); } } }
        { const int t = lane & 31, hh = lane >> 5;
#pragma unroll
          for (int r = 0; r < 16; ++r) { lg[t * 66 + crow(r, hh)] = l0[r]; lg[t * 66 + 32 + crow(r, hh)] = l1[r]; }
          if (TW == 36 && t < 4) {
#pragma unroll
              for (int r = 0; r < 16; ++r) { lg[(32 + t) * 66 + crow(r, hh)] = l2[r]; lg[(32 + t) * 66 + 32 + crow(r, hh)] = l3[r]; } } }
        LDS_WAIT();
        int se[6]; float sw_[6]; int lp[6];
        if (lane < TW) { LAS float* row = lg + lane * 66;
            float gs[8];
#pragma unroll
            for (int g = 0; g < 8; ++g) { float m1 = -INFINITY, m2 = -INFINITY;
#pragma unroll
                for (int j = 0; j < 8; ++j) { const int e = 8 * g + j; const float s = sigmoidf_(row[e]) + rbias[e]; row[e] = s; if (s > m1) { m2 = m1; m1 = s; } else if (s > m2) m2 = s; }
                gs[g] = m1 + m2; }
            unsigned gm = 0u;
#pragma unroll
            for (int k = 0; k < 4; ++k) { float best = -INFINITY; int bi = 0;
#pragma unroll
                for (int g = 0; g < 8; ++g) { const bool free_ = !((gm >> g) & 1u); if (free_ && gs[g] > best) { best = gs[g]; bi = g; } }
                gm |= 1u << bi; }
            int gsel = 0, nq = 0;
#pragma unroll
            for (int g = 0; g < 8; ++g) if ((gm >> g) & 1u) {
#pragma unroll
                for (int j = 0; j < 8; ++j) { const float t = row[g * 8 + j]; row[nq * 8 + j] = t; }
                gsel |= g << (3 * nq); ++nq; }
            float cs[32];
#pragma unroll
            for (int c = 0; c < 32; ++c) cs[c] = row[c];
            float wsum = 0.f;
#pragma unroll
            for (int k = 0; k < 6; ++k) { float best = cs[0]; int bi = 0;
#pragma unroll
                for (int c = 1; c < 32; ++c) if (cs[c] > best) { best = cs[c]; bi = c; }
#pragma unroll
                for (int c = 0; c < 32; ++c) cs[c] = (c == bi) ? -INFINITY : cs[c];
                const int be = ((gsel >> (3 * (bi >> 3))) & 7) * 8 + (bi & 7);
                se[k] = be; sw_[k] = best - rbias[be]; wsum += sw_[k]; }
            const float inv = 2.5f / wsum;
#pragma unroll
            for (int k = 0; k < 6; ++k) { sw_[k] *= inv; lp[k] = __hip_atomic_fetch_add(&mi[se[k]], 1, __ATOMIC_RELAXED, __HIP_MEMORY_SCOPE_WORKGROUP); }
        }
        __syncthreads();
        if (F.tid < 64) { const int c = mi[F.tid]; mi[64 + F.tid] = c ? (int)atomicAdd(&cnt[F.tid * 32], (unsigned)c) : 0; }
        __syncthreads();
        if (lane < TW) { const int g = gbase + lane;
#pragma unroll
            for (int k = 0; k < 6; ++k) { const int pos = mi[64 + se[k]] + lp[k]; list[(size_t)se[k] * CAP + pos] = g; tsel[(size_t)g * 8 + k] = (se[k] << 20) | pos; tgate[(size_t)g * 8 + k] = sw_[k]; } }
        __syncthreads();
    }
}
__device__ __forceinline__ void p_moe_prep(const Frame& F, const Args& a, int ly, const float* mods) {
    if (ly == 0 && F.G == 256) p_moe_prep_t<36>(F, a, ly, mods); else p_moe_prep_t<32>(F, a, ly, mods);
}
__device__ __forceinline__ void moe_tables(const Frame& F, int ly) {
    LAS int* mi = (LAS int*)(F.lds + MISC_OFF);
    __syncthreads();
    if (F.tid < 65) { const unsigned* cnt = (const unsigned*)(F.ws + WS_CTL) + CW_CNT + ly * 64 * 32;
        mi[512 + F.tid] = (F.tid < 64) ? (int)__hip_atomic_load(cnt + F.tid * 32, __ATOMIC_RELAXED, __HIP_MEMORY_SCOPE_AGENT) : (ly ? MLAT : MALL); }
    __syncthreads();
    if (F.tid == 0) { int ts = 0, rs = 0;
        for (int e = 0; e < 65; ++e) { const int n = mi[512 + e]; mi[256 + e] = ts; mi[384 + e] = rs; ts += (n + 255) >> 8; rs += n; }
        mi[256 + 65] = ts; mi[384 + 65] = rs; }
    __syncthreads();
}
struct MoeSched {
    LAS int* mi; int nN, G, c, ly, mode  , half;
    __device__ __forceinline__ bool next(int i, pg8::Unit& u) const {
        const int cx = (G == 256) ? ((c & 7) * 32 + (c >> 3)) : c;
        const int Ttot = mi[256 + 65], nfull = (Ttot / G) * nN, lane = threadIdx.x & 63;
        int T, pn;
        if (i < nfull) { T = (i / nN) * G + cx; pn = i % nN; }
        else { const int j = (i - nfull) * G + cx; if (j >= (Ttot % G) * nN) return false; T = (Ttot / G) * G + j / nN; pn = j % nN; }
        const int e = __builtin_amdgcn_readfirstlane(__popcll(__ballot(mi[256 + 1 + lane] <= T)));
        const int lt = T - mi[256 + e], n = mi[512 + e], r0 = mi[384 + e] + lt * 256;
        u.e = e; u.nv = (n - lt * 256) < 256 ? (n - lt * 256) : 256; u.cr = r0; u.cc = pn * 256;
        if (mode == 1) { u.ar = (e < 64 ? e : 64 + ly) * CAP + lt * 256; u.br = (ly * 65 + e) * 512 + pn * 256; }
        else { u.ar = r0; u.br = (ly * 65 + e) * 1024 + pn * 256; }
        return true;
    }
};
template <int FUSE> __device__ __forceinline__ void p_moe_combine(const Frame& F, int ly, const float* mods, float rscale, const float* gnext, const float* modsn, bf16_t* nxt, float* outp) {
    LAS int* mi = (LAS int*)(F.lds + MISC_OFF);
    bf16_t* xl = ws_bf(F, WS_XL); bf16_t* xc = ws_bf(F, WS_XC);
    const unsigned char* ya = (const unsigned char*)F.dout; const unsigned char* yb = F.ws + WS_YB;
    const int* tsel = (const int*)(F.ws + WS_TSEL); const float* tgate = ws_f32(F, WS_TGATE);
    const int gw = F.bid * 8 + F.wave, NGW = F.G * 8, lane = F.lane;
    const int NT = ly ? MLAT : MALL, shrow = mi[384 + 64];
    for (int i0 = gw; i0 < NT; i0 += 2 * NGW) {
        u32x4 yv[2][7], dv[2][2]; float wk[2][7]; f32x4 gg[2][4]; bf16_t* dstq[2]; int gq[2], mrq[2], lrq[2];
#pragma unroll
        for (int q = 0; q < 2; ++q) { const int ix = (i0 + q * NGW < NT) ? i0 + q * NGW : i0;
            int g, b, p; if (ly) { b = ix >> 11; p = CTXL + (ix & (SEQ - 1)); g = b * TPB + p; } else { g = ix; b = g / TPB; p = g - b * TPB; }
            gq[q] = g; mrq[q] = p < CTXL ? 32 : b; lrq[q] = b * SEQ + p - CTXL;
            dstq[q] = (p < CTXL ? xc + (size_t)(b * CTXL + p) * D : xl + (size_t)lrq[q] * D) + lane * 16;
#pragma unroll
            for (int k = 0; k < 7; ++k) { int row; if (k < 6) { const int ts = tsel[(size_t)g * 8 + k]; wk[q][k] = tgate[(size_t)g * 8 + k] * Y8_INV * rscale; row = mi[384 + (ts >> 20)] + (ts & 0xFFFFF); }
                else { wk[q][k] = Y8_INV * rscale; row = shrow + ix; }
                yv[q][k] = *(const u32x4*)((row < YSPLIT ? ya + (size_t)row * 1024 : yb + (size_t)(row - YSPLIT) * 1024) + lane * 16); }
            dv[q][0] = *(const u32x4*)dstq[q]; dv[q][1] = *(const u32x4*)(dstq[q] + 8);
            const float* gv = mods + (size_t)mrq[q] * 6144 + 5 * D + lane * 16;
#pragma unroll
            for (int c = 0; c < 4; ++c) gg[q][c] = *(const f32x4*)(gv + 4 * c); }
#pragma unroll
        for (int q = 0; q < 2; ++q) { if (q && i0 + NGW >= NT) continue;
            bf16_t* dst = dstq[q]; const int g = gq[q], mr = mrq[q];
            f32x4 o[4];
            { const u32x4 d0 = dv[q][0], d1 = dv[q][1];
              o[0] = (f32x4){bflo(d0.x), bfhi(d0.x), bflo(d0.y), bfhi(d0.y)}; o[1] = (f32x4){bflo(d0.z), bfhi(d0.z), bflo(d0.w), bfhi(d0.w)};
              o[2] = (f32x4){bflo(d1.x), bfhi(d1.x), bflo(d1.y), bfhi(d1.y)}; o[3] = (f32x4){bflo(d1.z), bfhi(d1.z), bflo(d1.w), bfhi(d1.w)}; }
            float acc[16];
#pragma unroll
            for (int j = 0; j < 16; ++j) acc[j] = 0.f;
#pragma unroll
            for (int k = 0; k < 7; ++k)
#pragma unroll
                for (int c = 0; c < 4; ++c) { const f32x2 lo = __builtin_amdgcn_cvt_pk_f32_fp8((int)yv[q][k][c], false), hi = __builtin_amdgcn_cvt_pk_f32_fp8((int)yv[q][k][c], true);
                    acc[4 * c] += wk[q][k] * lo[0]; acc[4 * c + 1] += wk[q][k] * lo[1]; acc[4 * c + 2] += wk[q][k] * hi[0]; acc[4 * c + 3] += wk[q][k] * hi[1]; }
            float ss = 0.f;
#pragma unroll
            for (int c = 0; c < 4; ++c) { o[c] += gg[q][c] * (f32x4){acc[4 * c], acc[4 * c + 1], acc[4 * c + 2], acc[4 * c + 3]};
                ss += o[c][0] * o[c][0] + o[c][1] * o[c][1] + o[c][2] * o[c][2] + o[c][3] * o[c][3]; }
            if (FUSE != 2) { u32x4 w0, w1; w0.x = pk2(o[0][0], o[0][1]); w0.y = pk2(o[0][2], o[0][3]); w0.z = pk2(o[1][0], o[1][1]); w0.w = pk2(o[1][2], o[1][3]);
                w1.x = pk2(o[2][0], o[2][1]); w1.y = pk2(o[2][2], o[2][3]); w1.z = pk2(o[3][0], o[3][1]); w1.w = pk2(o[3][2], o[3][3]); *(u32x4*)dst = w0; *(u32x4*)(dst + 8) = w1; }
            if (FUSE) { const float rs = rsqrtf(wave_sum(ss) * (1.f / D) + NORM_EPS);
                if (FUSE == 1) { const float* mv = modsn + (size_t)mr * 6144 + lane * 16; bf16_t* np = nxt + (size_t)g * D + lane * 16;
#pragma unroll
                    for (int c = 0; c < 4; ++c) { const f32x4 g4 = *(const f32x4*)(gnext + lane * 16 + 4 * c), sh = *(const f32x4*)(mv + 4 * c), sc = *(const f32x4*)(mv + D + 4 * c);
                        const f32x4 v = (o[c] * rs * g4) * (1.f + sc) + sh; u32x2 wv; wv.x = pk2(v[0], v[1]); wv.y = pk2(v[2], v[3]); *(u32x2*)(np + 4 * c) = wv; } }
                else { float* op = outp + (size_t)lrq[q] * D + lane * 16;
#pragma unroll
                    for (int c = 0; c < 4; ++c) { const f32x4 g4 = *(const f32x4*)(gnext + lane * 16 + 4 * c); *(f32x4*)(op + 4 * c) = o[c] * rs * g4; } } } } }
}

__device__ __forceinline__ void p_mla_prep(const Frame& F, const Args& a) {
    const bf16_t* cmp = (const bf16_t*)F.dout; bf16_t* cqn = ws_bf(F, WS_CQN); bf16_t* ckvn = ws_bf(F, WS_CKVN); bf16_t* kr = ws_bf(F, WS_KR); const float* rope = ws_f32(F, WS_ROPE);
    const float* qn = a.in[I_MLAQN]; const float* kvn = a.in[I_MLAKVN];
    const int gw = F.bid * 8 + F.wave, NGW = F.G * 8, lane = F.lane;
    const f32x4 gkv = *(const f32x4*)(kvn + lane * 4); float gq[6];
#pragma unroll
    for (int j = 0; j < 6; ++j) gq[j] = qn[lane * 6 + j];
    u32x2 rkv[4]; unsigned rq[4][3]; bf16_t rr[4];
#define MP_LOAD(G0, RKV, RQ, RR) do { _Pragma("unroll") for (int q = 0; q < 4; ++q) { const int gi_ = ((G0) + q * NGW < MALL) ? (G0) + q * NGW : gw; const bf16_t* row = cmp + (size_t)gi_ * MLAP; \
            RKV[q] = *(const u32x2*)(row + 384 + lane * 4); const unsigned* rw = (const unsigned*)(row + lane * 6); RQ[q][0] = rw[0]; RQ[q][1] = rw[1]; RQ[q][2] = rw[2]; RR[q] = row[640 + (lane & 31)]; } } while (0)
    MP_LOAD(gw, rkv, rq, rr);
    for (int g0 = gw; g0 < MALL; g0 += 4 * NGW) {
        u32x2 nkv[4]; unsigned nq[4][3]; bf16_t nr[4];
        MP_LOAD(g0 + 4 * NGW, nkv, nq, nr);
#pragma unroll
        for (int q = 0; q < 4; ++q) { const int g = g0 + q * NGW; if (g >= MALL) continue; const int b = g / TPB, p = g - b * TPB;
            { const float v[4] = {bflo(rkv[q].x), bfhi(rkv[q].x), bflo(rkv[q].y), bfhi(rkv[q].y)};
              const float ss = wave_sum(v[0] * v[0] + v[1] * v[1] + v[2] * v[2] + v[3] * v[3]); const float rs = rsqrtf(ss * (1.f / 256.f) + NORM_EPS);
              u32x2 o; o.x = pk2(v[0] * rs * gkv[0], v[1] * rs * gkv[1]); o.y = pk2(v[2] * rs * gkv[2], v[3] * rs * gkv[3]); *(u32x2*)(ckvn + (size_t)g * 256 + lane * 4) = o; }
            { float x = (lane < 32) ? bf2f(rr[q]) : 0.f;
              if (p >= CTXL) { const int t = p - CTXL; const float other = __shfl_xor(x, 16); const int i = lane & 15; const float cs = rope[t * 16 + i], sn = rope[SEQ * 16 + t * 16 + i];
                  x = (lane & 16) ? (other * sn + x * cs) : (x * cs - other * sn); }
              if (lane < 32) kr[(size_t)g * 32 + lane] = f2bf(x); }
            if (p >= CTXL) { const size_t lr = (size_t)(b * SEQ + p - CTXL);
                const float v[6] = {bflo(rq[q][0]), bfhi(rq[q][0]), bflo(rq[q][1]), bfhi(rq[q][1]), bflo(rq[q][2]), bfhi(rq[q][2])};
                const float ss = wave_sum(v[0] * v[0] + v[1] * v[1] + v[2] * v[2] + v[3] * v[3] + v[4] * v[4] + v[5] * v[5]); const float rs = rsqrtf(ss * (1.f / 384.f) + NORM_EPS);
                unsigned* o = (unsigned*)(cqn + lr * 384 + lane * 6);
                o[0] = pk2(v[0] * rs * gq[0], v[1] * rs * gq[1]); o[1] = pk2(v[2] * rs * gq[2], v[3] * rs * gq[3]); o[2] = pk2(v[4] * rs * gq[4], v[5] * rs * gq[5]); } }
#pragma unroll
        for (int q = 0; q < 4; ++q) { rkv[q] = nkv[q]; rq[q][0] = nq[q][0]; rq[q][1] = nq[q][1]; rq[q][2] = nq[q][2]; rr[q] = nr[q]; } }
#undef MP_LOAD
}
constexpr int AT_KO = 0, AT_RO = 8192, AT_VO = 12288, AT_STAGE = 20480;
__device__ __forceinline__ void p_attention(const Frame& F) {
    const bf16_t* Q = ws_bf(F, WS_Q); const bf16_t* KN = ws_bf(F, WS_KN); const bf16_t* KR = ws_bf(F, WS_KR); const bf16_t* VT = (const bf16_t*)F.dout; bf16_t* O = ws_bf(F, WS_O);
    const int tid = F.tid, lane = F.lane, w = F.wave, r32 = lane & 31, hh = lane >> 5;
    LAS unsigned char* L = F.lds;
    const int nIt = (F.G == 256) ? (NB * 16 * 4) / 256 : (NB * 16 * 4 + F.G - 1) / F.G;
    for (int it = 0; it < nIt; ++it) {
        int bh, qb;
        if (F.G == 256) { const int xcd = F.bid & 7, slot = F.bid >> 3; bh = (it * 8 + (slot >> 2)) * 8 + xcd; qb = slot & 3; }
        else { const int U = it * F.G + F.bid; if (U >= NB * 16 * 4) break; bh = U >> 2; qb = U & 3; }
        const int b = bh >> 4, h = bh & 15;
        const size_t qrow = (size_t)b * SEQ + qb * 512 + w * 64 + r32;
        bf16x8 qf[2][6];
#pragma unroll
        for (int qi = 0; qi < 2; ++qi)
#pragma unroll
            for (int s = 0; s < 6; ++s) qf[qi][s] = *(const bf16x8*)(Q + (qrow + 32 * qi) * 1536 + h * 96 + 16 * s + 8 * hh);
        const size_t kv0g = (size_t)b * TPB;
        const bf16_t* kp = KN + (kv0g + lane) * 1024 + h * 64 + w * 8;
        const bf16_t* rp = KR + (kv0g + lane) * 32 + (w & 3) * 8;
        const bf16_t* vp = VT + (size_t)(h * 64 + lane) * MALL + kv0g + w * 8;
        const int kb = hh * 1024 + r32 * 16, vb = AT_VO + r32 * 16 + 8 * hh;
#define AT_DMA(t, stg) do { __builtin_amdgcn_global_load_lds((const unsigned*)(kp + (size_t)(t) * 64 * 1024), (LAS unsigned*)((stg) + AT_KO + w * 1024), 16, 0, 0); \
            if (w < 4) __builtin_amdgcn_global_load_lds((const unsigned*)(rp + (size_t)(t) * 64 * 32), (LAS unsigned*)((stg) + AT_RO + w * 1024), 16, 0, 0); \
            __builtin_amdgcn_global_load_lds((const unsigned*)(vp + (t) * 64), (LAS unsigned*)((stg) + AT_VO + w * 1024), 16, 0, 0); } while (0)
        AT_DMA(0, L);
        __syncthreads();
        f32x16 o[2][2]; float mrun[2] = {0.f, 0.f}, lsum[2] = {0.f, 0.f};
#pragma unroll
        for (int qi = 0; qi < 2; ++qi) { o[qi][0] = ZERO16; o[qi][1] = ZERO16; }
        constexpr int NT = TPB / 64;
        for (int t = 0; t < NT; ++t) {
            LAS unsigned char* cur = L + (t & 1) * AT_STAGE; LAS unsigned char* nxt = L + ((t + 1) & 1) * AT_STAGE;
            if (t + 1 < NT) AT_DMA(t + 1, nxt);
            f32x16 p[2][2];
#pragma unroll
            for (int qi = 0; qi < 2; ++qi) { const float nm = -mrun[qi];
#pragma unroll
                for (int r = 0; r < 16; ++r) { p[qi][0][r] = nm; p[qi][1][r] = nm; } }
#pragma unroll
            for (int s = 0; s < 6; ++s) { const bf16x8 k0 = *(const LAS bf16x8*)(cur + kb + s * 2048), k1 = *(const LAS bf16x8*)(cur + kb + s * 2048 + 512);
#pragma unroll
                for (int qi = 0; qi < 2; ++qi) { p[qi][0] = __builtin_amdgcn_mfma_f32_32x32x16_bf16(k0, qf[qi][s], p[qi][0], 0, 0, 0); p[qi][1] = __builtin_amdgcn_mfma_f32_32x32x16_bf16(k1, qf[qi][s], p[qi][1], 0, 0, 0); } }
            float mx[2];
#pragma unroll
            for (int qi = 0; qi < 2; ++qi) { const f32x16& p0 = p[qi][0]; const f32x16& p1 = p[qi][1];
                float ma = fmaxf(fmaxf(p0[0], p0[1]), p1[0]), mb = fmaxf(fmaxf(p0[2], p0[3]), p1[1]); ma = fmaxf(fmaxf(ma, p1[2]), p1[3]);
#pragma unroll
                for (int r = 4; r < 16; r += 4) { ma = fmaxf(fmaxf(ma, p0[r]), p0[r + 1]); mb = fmaxf(fmaxf(mb, p0[r + 2]), p0[r + 3]); ma = fmaxf(fmaxf(ma, p1[r]), p1[r + 1]); mb = fmaxf(fmaxf(mb, p1[r + 2]), p1[r + 3]); }
                float m_ = fmaxf(ma, mb);
                auto rr = __builtin_amdgcn_permlane32_swap(__float_as_uint(m_), __float_as_uint(m_), false, false); mx[qi] = fmaxf(__uint_as_float(rr[0]), __uint_as_float(rr[1])); }
            if (t == 0 || __any(fmaxf(mx[0], mx[1]) > 8.f)) {
#pragma unroll
                for (int qi = 0; qi < 2; ++qi) { const float dl = (t == 0) ? mx[qi] : fmaxf(mx[qi], 0.f); mrun[qi] += dl; const float alpha = __builtin_amdgcn_exp2f(-dl); lsum[qi] *= alpha;
#pragma unroll
                    for (int r = 0; r < 16; ++r) { p[qi][0][r] -= dl; p[qi][1][r] -= dl; o[qi][0][r] *= alpha; o[qi][1][r] *= alpha; } } }
#pragma unroll
            for (int qi = 0; qi < 2; ++qi) { float ps = 0.f;
#pragma unroll
                for (int r = 0; r < 16; ++r) { p[qi][0][r] = __builtin_amdgcn_exp2f(p[qi][0][r]); p[qi][1][r] = __builtin_amdgcn_exp2f(p[qi][1][r]); ps += p[qi][0][r] + p[qi][1][r]; }
                lsum[qi] += ps; }
#pragma unroll
            for (int kvh = 0; kvh < 2; ++kvh)
#pragma unroll
                for (int s2 = 0; s2 < 2; ++s2) { const int c = kvh * 4 + 2 * s2;
                    const u32x2 a00 = *(const LAS u32x2*)(cur + vb + c * 1024), a01 = *(const LAS u32x2*)(cur + vb + c * 1024 + 1024);
                    const u32x2 a10 = *(const LAS u32x2*)(cur + vb + c * 1024 + 512), a11 = *(const LAS u32x2*)(cur + vb + c * 1024 + 1536);
                    const bf16x8 va0 = __builtin_bit_cast(bf16x8, (u32x4){a00.x, a00.y, a01.x, a01.y}), va1 = __builtin_bit_cast(bf16x8, (u32x4){a10.x, a10.y, a11.x, a11.y});
#pragma unroll
                    for (int qi = 0; qi < 2; ++qi) { const f32x16& pp = p[qi][kvh]; u32x4 pw; pw.x = pk2(pp[8 * s2], pp[8 * s2 + 1]); pw.y = pk2(pp[8 * s2 + 2], pp[8 * s2 + 3]); pw.z = pk2(pp[8 * s2 + 4], pp[8 * s2 + 5]); pw.w = pk2(pp[8 * s2 + 6], pp[8 * s2 + 7]);
                        const bf16x8 pb = __builtin_bit_cast(bf16x8, pw);
                        o[qi][0] = __builtin_amdgcn_mfma_f32_32x32x16_bf16(va0, pb, o[qi][0], 0, 0, 0); o[qi][1] = __builtin_amdgcn_mfma_f32_32x32x16_bf16(va1, pb, o[qi][1], 0, 0, 0); } }
            __syncthreads();
        }
#undef AT_DMA
#pragma unroll
        for (int qi = 0; qi < 2; ++qi) { float ls = lsum[qi]; ls += __shfl_xor(ls, 32); const float il = __builtin_amdgcn_rcpf(ls);
            bf16_t* op = O + (qrow + 32 * qi) * D + h * 64;
#pragma unroll
            for (int g = 0; g < 4; ++g) { const f32x16& o0 = o[qi][0]; const f32x16& o1 = o[qi][1];
                u32x2 a0, a1; a0.x = pk2(o0[4 * g] * il, o0[4 * g + 1] * il); a0.y = pk2(o0[4 * g + 2] * il, o0[4 * g + 3] * il); a1.x = pk2(o1[4 * g] * il, o1[4 * g + 1] * il); a1.y = pk2(o1[4 * g + 2] * il, o1[4 * g + 3] * il);
                *(u32x2*)(op + 8 * g + 4 * hh) = a0; *(u32x2*)(op + 32 + 8 * g + 4 * hh) = a1; } }
    }
}
__device__ __forceinline__ void p_final(const Frame& F, const Args& a) {
    const bf16_t* xl = ws_bf(F, WS_XL); const float* gw = a.in[I_FNORM]; float* out = (float*)F.dout;
    const int gwv = F.bid * 8 + F.wave, NGW = F.G * 8, lane = F.lane;
    for (int r0 = gwv; r0 < MLAT; r0 += 4 * NGW) { u32x4 raw[4][2]; float ss[4];
#pragma unroll
        for (int q = 0; q < 4; ++q)
#pragma unroll
            for (int j = 0; j < 2; ++j) raw[q][j] = *(const u32x4*)(xl + (size_t)(r0 + q * NGW < MLAT ? r0 + q * NGW : r0) * D + 8 * lane + 512 * j);
#pragma unroll
        for (int q = 0; q < 4; ++q) { float s = 0.f;
#pragma unroll
            for (int j = 0; j < 2; ++j) { float v[8]; unpack8(raw[q][j], v);
#pragma unroll
                for (int c = 0; c < 8; ++c) s += v[c] * v[c]; }
            ss[q] = rsqrtf(wave_sum(s) * (1.f / D) + NORM_EPS); }
#pragma unroll
        for (int j = 0; j < 2; ++j) { const int c0 = 8 * lane + 512 * j; const f32x4 g0 = *(const f32x4*)(gw + c0), g1 = *(const f32x4*)(gw + c0 + 4);
#pragma unroll
            for (int q = 0; q < 4; ++q) { if (r0 + q * NGW >= MLAT) continue; float v[8]; unpack8(raw[q][j], v); float* op = out + (size_t)(r0 + q * NGW) * D + c0;
                *(f32x4*)op = (f32x4){v[0], v[1], v[2], v[3]} * ss[q] * g0; *(f32x4*)(op + 4) = (f32x4){v[4], v[5], v[6], v[7]} * ss[q] * g1; } } }
}

constexpr int N_PHASES = 20;
__global__ void __launch_bounds__(512, 2) fwd_kernel(Args args) {
    extern __shared__ __attribute__((aligned(16))) unsigned char lds_raw[];
    Frame F;
    F.lds = (LAS unsigned char*)lds_raw;
    F.tid = threadIdx.x; F.lane = F.tid & 63; F.wave = __builtin_amdgcn_readfirstlane(F.tid >> 6);
    F.G = gridDim.x; F.bid = blockIdx.x; F.ws = args.ws; F.dout = (unsigned char*)args.out;
    volatile LAS unsigned* BW = (volatile LAS unsigned*)(F.lds + MISC_OFF + 12288);
    if (F.tid == 0) { BW[0] = 0u; BW[1] = 0u; BW[2] = 0u; BW[3] = 0u; }
    __syncthreads();
    XcdBarrier bar; bar.bar = (unsigned*)(F.ws + WS_CTL) + CW_BAR; bar.x = 0; bar.st = nullptr;
    if (!MK_PER_PHASE) bar = xcd_barrier_post((unsigned*)(F.ws + WS_CTL) + CW_BAR, BW);
    const int lo = args.ph_lo, hi = args.ph_hi;
#ifndef PHMASK
#define PHMASK 0xFFFFFFFFu
#endif
#define IN(k) (((PHMASK >> (k)) & 1u) && lo <= (k) && (k) < hi)
#ifndef REP_PHASE
#define REP_PHASE -1
#endif
#define NREP(k) (((k) == REP_PHASE) ? 2 : 1)
#define REPL(k) for (int rep_ = 0; rep_ < NREP(k); ++rep_)
#define REPB() do { if (rep_) { if (!MK_PER_PHASE) xcd_barrier(bar); } } while (0)
#define SEAM(k) do { if (IN(k) && IN((k) + 1)) { if (!MK_PER_PHASE) xcd_barrier(bar); } } while (0)
#define XTASK(t) ((F.G == 256) ? (((((t) >> 3) >> 3) * 8 + ((t) & 7)) * 8 + (((t) >> 3) & 7)) : (t))
    const float* mods0 = ws_f32(F, WS_MODS); const float* mods1 = mods0 + 33 * 6144;
    LAS int* mi = (LAS int*)(F.lds + MISC_OFF);

    if (IN(0)) REPL(0) { REPB(); p0_mods(F, args); p0_convert(F, args); } SEAM(0);
    if (IN(1)) REPL(1) { REPB(); p_normmod(F, args.in[I_X], args.in[I_CTX], args.in[I_NMIX], mods0, 0, (bf16_t*)F.dout); } SEAM(1);
    if (IN(2)) REPL(2) { REPB(); pg8::Gemm g{(const bf16_t*)F.dout, ws_bf(F, WS_WIN), D, D, D, nullptr}; pg8::DenseSched S; S.init(MALL, EVP, F.G, F.bid); EpiBf16 E{ws_bf(F, WS_COLS), EVP};
        pg8::gemm_phase<EpiBf16, pg8::DenseSched, false>(F.lds + RING_OFF, g, S, E); } SEAM(2);
    if (IN(3)) REPL(3) { REPB(); Drip drip; drip.c = 0;
#pragma unroll
        for (int j = 0; j < 8; ++j) { drip.v[j] = 0.f; drip.v2[j] = 0.f; }
        for (int r2 = 0; r2 < (REP_PHASE == 103 ? 2 : 1); ++r2) for (int t = F.bid; t < 256; t += F.G) rwkv_task(F, args, XTASK(t)); for (int r2 = 0; r2 < (REP_PHASE == 104 ? 2 : 1); ++r2) for (int t = F.bid; t < 256; t += F.G) ssd_task(F, args, XTASK(t), drip);
        while (2 * drip.c * F.G * 8 < DRIP_UNITS) { drip_issue(F, args, drip, F.lane); drip_store(F, args, drip, F.lane); } } SEAM(3);
    if (IN(4)) REPL(4) { REPB(); p_ssm_norm(F, args); } SEAM(4);
    if (IN(5)) REPL(5) { REPB(); pg8::Gemm g{(const bf16_t*)F.dout, ws_bf(F, WS_WOUT), MIXD, MIXD, MIXD, nullptr}; pg8::DenseSched S; S.init(MALL, D, F.G, F.bid);
        EpiResid<0> E{args.in[I_X], args.in[I_CTX], ws_bf(F, WS_XL), ws_bf(F, WS_XC), mods0};
        pg8::gemm_phase<EpiResid<0>, pg8::DenseSched, false>(F.lds + RING_OFF, g, S, E); } SEAM(5);
#define MOE_PHASES(P, ly, modsL) \
    if (IN(P)) { p_moe_prep(F, args, ly, modsL); } SEAM(P); \
    if (IN((P) + 1)) REPL((P) + 1) { REPB(); moe_tables(F, ly); pg8::Gemm g{ws_bf(F, WS_TOK), ws_bf(F, WS_W13), D, D, D, (const int*)(F.ws + WS_LIST)}; MoeSched S{mi, 2, F.G, F.bid, ly, 1, 0}; EpiGlu E{ws_bf(F, WS_HID)}; \
        pg8::gemm_phase<EpiGlu, MoeSched, true>(F.lds + RING_OFF, g, S, E); } SEAM((P) + 1); \
    if (IN((P) + 2)) REPL((P) + 2) { REPB(); moe_tables(F, ly); pg8::Gemm g{ws_bf(F, WS_HID), ws_bf(F, WS_W2E), EFF, EFF, EFF, nullptr}; MoeSched S{mi, 4, F.G, F.bid, ly, 2, 0}; \
        EpiMoeDown E{F.dout, F.ws + WS_YB}; \
        pg8::gemm_phase<EpiMoeDown, MoeSched, false>(F.lds + RING_OFF, g, S, E); } SEAM((P) + 2); \
    if (IN((P) + 3)) { moe_tables(F, ly); COMBINE_CALL; } SEAM((P) + 3);
#define COMBINE_CALL p_moe_combine<1>(F, 0, mods0, 1.f, args.in[I_NMIX] + D, mods1, ws_bf(F, WS_HA1), nullptr)
    MOE_PHASES(6, 0, mods0)
#undef COMBINE_CALL
    if (IN(10)) REPL(10) { REPB(); pg8::Gemm g{ws_bf(F, WS_HA1), ws_bf(F, WS_WMLA), D, D, D, nullptr}; pg8::DenseSched S; S.init(MALL, MLAP, F.G, F.bid); EpiBf16 E{(bf16_t*)F.dout, MLAP};
        pg8::gemm_phase<EpiBf16, pg8::DenseSched, false>(F.lds + RING_OFF, g, S, E); } SEAM(10);
    if (IN(11)) REPL(11) { REPB(); p_mla_prep(F, args); } SEAM(11);
    if (IN(12)) REPL(12) { REPB();
        { pg8::Gemm g{ws_bf(F, WS_CQN), ws_bf(F, WS_WQ), 384, 384, 384, nullptr}; pg8::DenseSched S; S.init(MLAT, 1536, F.G, F.bid); EpiQ E{ws_bf(F, WS_Q), ws_f32(F, WS_ROPE)};
          pg8::gemm_phase<EpiQ, pg8::DenseSched, false>(F.lds + RING_OFF, g, S, E); }
        { pg8::Gemm g{ws_bf(F, WS_CKVN), ws_bf(F, WS_WK), 256, 256, 256, nullptr}; pg8::DenseSched S; S.init(MALL, 1024, F.G, F.bid); EpiBf16 E{ws_bf(F, WS_KN), D};
          pg8::gemm_phase<EpiBf16, pg8::DenseSched, false>(F.lds + RING_OFF, g, S, E); }
        { pg8::Gemm g{ws_bf(F, WS_WV), ws_bf(F, WS_CKVN), 256, 256, 256, nullptr}; pg8::DenseSched S; S.init(1024, MALL, F.G, F.G - 1 - F.bid); EpiBf16 E{(bf16_t*)F.dout, MALL};
          pg8::gemm_phase<EpiBf16, pg8::DenseSched, false>(F.lds + RING_OFF, g, S, E); }
    } SEAM(12);
    if (IN(13)) REPL(13) { REPB(); p_attention(F); } SEAM(13);
    if (IN(14)) { pg8::Gemm g{ws_bf(F, WS_O), ws_bf(F, WS_WO), D, D, D, nullptr}; pg8::DenseSched S; S.init(MLAT, D, F.G, F.bid);
        EpiResid<1> E{nullptr, nullptr, ws_bf(F, WS_XL), nullptr, mods1};
        pg8::gemm_phase<EpiResid<1>, pg8::DenseSched, false>(F.lds + RING_OFF, g, S, E); } SEAM(14);
#define COMBINE_CALL p_moe_combine<0>(F, 1, mods1, 1.f, nullptr, nullptr, nullptr, nullptr)
    MOE_PHASES(15, 1, mods1)
#undef COMBINE_CALL
    if (IN(19)) { p_final(F, args); }
#undef IN
#undef SEAM
}

extern "C" void kernel_launch(void* const* d_in, const int* in_sizes, int n_in, void* d_out, int out_size, void* d_ws, size_t ws_size, hipStream_t stream) {
    static int grid = 0;
    if (grid == 0) {
        if (n_in != 42 || out_size != MLAT * D || ws_size < WS_END) { fprintf(stderr, "kernel_launch: unexpected shapes: n_in %d out %d ws %zu (need %zu)\n", n_in, out_size, ws_size, (size_t)WS_END); grid = -1; return; }
        int dev = 0, cus = 0, per_cu = 0;
        if (hipGetDevice(&dev) != hipSuccess || hipDeviceGetAttribute(&cus, hipDeviceAttributeMultiprocessorCount, dev) != hipSuccess) { grid = -1; return; }
        if (hipFuncSetAttribute((const void*)fwd_kernel, hipFuncAttributeMaxDynamicSharedMemorySize, LDS_BYTES) != hipSuccess) { fprintf(stderr, "kernel_launch: hipFuncSetAttribute failed\n"); grid = -1; return; }
        if (hipOccupancyMaxActiveBlocksPerMultiprocessor(&per_cu, (const void*)fwd_kernel, 512, LDS_BYTES) != hipSuccess || per_cu < 1) fprintf(stderr, "kernel_launch: occupancy query says %d\n", per_cu);
        (void)hipGetLastError();
        grid = cus;
    }
    if (grid < 0) return;
    (void)hipMemsetAsync((char*)d_ws + WS_CTL, 0, CTL_BYTES, stream);
    Args a{};
    for (int i = 0; i < 42; ++i) a.in[i] = (const float*)d_in[i];
    a.out = (float*)d_out; a.ws = (unsigned char*)d_ws;
#if MK_PER_PHASE
    for (int p = 0; p < N_PHASES; ++p) { a.ph_lo = p; a.ph_hi = p + 1; hipLaunchKernelGGL(fwd_kernel, dim3(grid), dim3(512), LDS_BYTES, stream, a); }
#else
    a.ph_lo = 0; a.ph_hi = N_PHASES; hipLaunchKernelGGL(fwd_kernel, dim3(grid), dim3(512), LDS_BYTES, stream, a);
#endif
}
```
